# Optimizing an MI355X kernel written in HIP

```python
import math
import jax, jax.numpy as jnp
from jax import lax
import numpy as np

D_MODEL = 2048
BATCH = 8
SEQ = 2048
DEPTH = 2

HEAD_DIM = 128
N_HEADS_DIFF = 8
DIFF_MAP_DIM = HEAD_DIM // 2
N_HEADS_SB = 8
N_HEADS_MOBA = 8
MIX_W = 8 * HEAD_DIM
N_BRANCH = 3
MOBA_BLOCK = 256
MOBA_TOPK = 3
Q_BLOCK = 128
MOBA_Q_CHUNK = 16
D_FF = -(-8 * D_MODEL // (3 * 256)) * 256
RMS_EPS = 1e-6
COL_WIDTHS = [N_HEADS_DIFF * 2 * DIFF_MAP_DIM, N_HEADS_DIFF * 2 * DIFF_MAP_DIM, N_HEADS_DIFF * HEAD_DIM,
              N_HEADS_SB * HEAD_DIM, N_HEADS_SB * HEAD_DIM, N_HEADS_SB * HEAD_DIM,
              N_HEADS_MOBA * HEAD_DIM, N_HEADS_MOBA * HEAD_DIM, N_HEADS_MOBA * HEAD_DIM,
              N_BRANCH * D_MODEL]
N_COLS = sum(COL_WIDTHS)
COL_OFFSETS = [int(o) for o in np.cumsum(COL_WIDTHS)[:-1]]
N_ALIBI = N_HEADS_DIFF + N_HEADS_MOBA
ALIBI_ALL = 2.0 ** (-8.0 * (np.arange(N_ALIBI) + 1) / N_ALIBI)
ALIBI_DIFF = ALIBI_ALL[0::2].astype(np.float32)
ALIBI_MOBA = ALIBI_ALL[1::2].astype(np.float32)

kernel_name = 'hybrid_diff_stickbreak_moba_gated'


def rms_norm(x, g):
    xf = x.astype(jnp.float32)
    y = xf * lax.rsqrt(jnp.mean(xf * xf, axis=-1, keepdims=True) + RMS_EPS)
    return (y * g.astype(jnp.float32)).astype(x.dtype)


def _split_heads(t, n):
    b, s, _ = t.shape
    return t.reshape(b, s, n, -1).transpose(0, 2, 1, 3)


def _merge_heads(o):
    b, h, s, d = o.shape
    return o.transpose(0, 2, 1, 3).reshape(b, s, h * d)


def _blocks(q, size):
    b, h, s = q.shape[:3]
    rest = q.shape[3:]
    qb = q.reshape((b, h, s // size, size) + rest)
    return jnp.moveaxis(qb, 2, 0)


def _unblocks(o):
    nq, b, h, size, d = o.shape
    return jnp.moveaxis(o, 0, 2).reshape(b, h, nq * size, d)


def diff_attention(q, k, v, lam, subln_w, lambda_init):
    b, h, s, _, dm = q.shape
    scale = dm ** -0.5
    kpos = jnp.arange(s)
    slopes = jnp.asarray(ALIBI_DIFF)
    nq = s // Q_BLOCK

    def block(args):
        qi, i = args
        t = i * Q_BLOCK + jnp.arange(Q_BLOCK)
        sc = jnp.einsum('bhqmd,bhkmd->bhmqk', qi, k).astype(jnp.float32) * scale
        dist = (t[:, None] - kpos[None, :]).astype(jnp.float32)
        sc = sc - (slopes[:, None, None] * dist[None])[None, :, None]
        sc = jnp.where(kpos[None, :] <= t[:, None], sc, -jnp.inf)
        p = jax.nn.softmax(sc, axis=-1)
        a = p[:, :, 0] - lam * p[:, :, 1]
        return jnp.einsum('bhqk,bhkd->bhqd', a.astype(v.dtype), v)

    o = _unblocks(lax.map(block, (_blocks(q, Q_BLOCK), jnp.arange(nq))))
    o = rms_norm(o, subln_w).astype(jnp.float32) * (1.0 - lambda_init)
    return o.astype(v.dtype)


def stick_breaking_attention(q, k, v):
    b, h, s, d = q.shape
    scale = d ** -0.5
    kpos = jnp.arange(s)
    nq = s // Q_BLOCK

    def block(args):
        qi, i = args
        t = i * Q_BLOCK + jnp.arange(Q_BLOCK)
        z = jnp.einsum('bhqd,bhkd->bhqk', qi, k).astype(jnp.float32) * scale
        strict = kpos[None, :] < t[:, None]
        log_fail = jnp.where(strict, jax.nn.log_sigmoid(-z), 0.0)
        suffix = lax.cumsum(log_fail, axis=log_fail.ndim - 1, reverse=True) - log_fail
        w = jnp.where(strict, jnp.exp(jax.nn.log_sigmoid(z) + suffix), 0.0)
        return jnp.einsum('bhqk,bhkd->bhqd', w.astype(v.dtype), v)

    return _unblocks(lax.map(block, (_blocks(q, Q_BLOCK), jnp.arange(nq))))


def moba_attention(q, k, v):
    b, h, s, d = q.shape
    scale = d ** -0.5
    slopes = jnp.asarray(ALIBI_MOBA)
    nb = -(-s // MOBA_BLOCK)
    pad = nb * MOBA_BLOCK - s
    kp = jnp.pad(k, ((0, 0), (0, 0), (0, pad), (0, 0))).reshape(b, h, nb, MOBA_BLOCK, d)
    vp = jnp.pad(v, ((0, 0), (0, 0), (0, pad), (0, 0))).reshape(b, h, nb, MOBA_BLOCK, d)
    kmean = jnp.mean(kp.astype(jnp.float32), axis=3)
    k_sel = max(1, min(MOBA_TOPK, nb - 1))
    bi = jnp.arange(b)[:, None, None, None]
    hi = jnp.arange(h)[None, :, None, None]
    blk = jnp.arange(MOBA_BLOCK)
    nc = s // MOBA_Q_CHUNK

    def chunk(args):
        qi, c = args
        t = c * MOBA_Q_CHUNK + jnp.arange(MOBA_Q_CHUNK)
        own = (c * MOBA_Q_CHUNK) // MOBA_BLOCK
        gate = jnp.einsum('bhqd,bhnd->bhqn', qi.astype(jnp.float32), kmean)
        gate = jnp.where(jnp.arange(nb) < own, gate, -jnp.inf)
        _, idx = lax.top_k(gate, k_sel)
        valid = idx < own
        ksel = kp[bi, hi, idx]
        vsel = vp[bi, hi, idx]
        pos_sel = idx[..., None] * MOBA_BLOCK + blk
        s_sel = jnp.einsum('bhqd,bhqkpd->bhqkp', qi, ksel).astype(jnp.float32) * scale
        s_sel = s_sel - slopes[None, :, None, None, None] * (t[None, None, :, None, None] - pos_sel).astype(jnp.float32)
        s_sel = jnp.where(valid[..., None], s_sel, -jnp.inf)
        kown = lax.dynamic_index_in_dim(kp, own, axis=2, keepdims=False)
        vown = lax.dynamic_index_in_dim(vp, own, axis=2, keepdims=False)
        pos_own = own * MOBA_BLOCK + blk
        s_own = jnp.einsum('bhqd,bhpd->bhqp', qi, kown).astype(jnp.float32) * scale
        s_own = s_own - slopes[:, None, None] * (t[:, None] - pos_own[None, :]).astype(jnp.float32)
        s_own = jnp.where(pos_own[None, :] <= t[:, None], s_own, -jnp.inf)
        s_all = jnp.concatenate([s_sel.reshape(b, h, MOBA_Q_CHUNK, k_sel * MOBA_BLOCK), s_own], axis=-1)
        p = jax.nn.softmax(s_all, axis=-1).astype(v.dtype)
        p_sel = p[..., :k_sel * MOBA_BLOCK].reshape(b, h, MOBA_Q_CHUNK, k_sel, MOBA_BLOCK)
        p_own = p[..., k_sel * MOBA_BLOCK:]
        return (jnp.einsum('bhqkp,bhqkpd->bhqd', p_sel, vsel)
                + jnp.einsum('bhqp,bhpd->bhqd', p_own, vown))

    return _unblocks(lax.map(chunk, (_blocks(q, MOBA_Q_CHUNK), jnp.arange(nc))))


def hybrid_mixer(h, w_in, b_gate, lam_q1, lam_k1, lam_q2, lam_k2, subln_w, w_branch, w_out, lambda_init):
    b, s, _ = h.shape
    proj = h @ w_in
    qa, ka, va, qb, kb, vb, qc, kc, vc, g = jnp.split(proj, COL_OFFSETS, axis=-1)
    qa = _split_heads(qa, N_HEADS_DIFF).reshape(b, N_HEADS_DIFF, s, 2, DIFF_MAP_DIM)
    ka = _split_heads(ka, N_HEADS_DIFF).reshape(b, N_HEADS_DIFF, s, 2, DIFF_MAP_DIM)
    lam = (jnp.exp(jnp.sum(lam_q1.astype(jnp.float32) * lam_k1.astype(jnp.float32)))
           - jnp.exp(jnp.sum(lam_q2.astype(jnp.float32) * lam_k2.astype(jnp.float32))) + lambda_init)
    o_a = diff_attention(qa, ka, _split_heads(va, N_HEADS_DIFF), lam, subln_w, lambda_init)
    o_b = stick_breaking_attention(_split_heads(qb, N_HEADS_SB), _split_heads(kb, N_HEADS_SB), _split_heads(vb, N_HEADS_SB))
    o_c = moba_attention(_split_heads(qc, N_HEADS_MOBA), _split_heads(kc, N_HEADS_MOBA), _split_heads(vc, N_HEADS_MOBA))
    br = jnp.stack([_merge_heads(o_a), _merge_heads(o_b), _merge_heads(o_c)], axis=2)
    z = jnp.einsum('bsnm,nmd->bsnd', br, w_branch)
    gates = jax.nn.sigmoid((g + b_gate).reshape(b, s, N_BRANCH, D_MODEL))
    merged = jnp.sum(gates * z, axis=2)
    return merged @ w_out


def swiglu(h, w_gate, w_up, w_down):
    return (jax.nn.silu(h @ w_gate) * (h @ w_up)) @ w_down


def setup_inputs(seed: int = 0) -> dict:
    key = jax.random.key(seed)
    ks = jax.random.split(key, 16)
    f32 = jnp.float32
    nrm = lambda k, shape, sc: jax.random.normal(k, shape, f32) * sc
    out_sc = (2.0 * DEPTH) ** -0.5
    return {
        'x': nrm(ks[0], (BATCH, SEQ, D_MODEL), 1.0),
        'norm_mix_g': 1.0 + nrm(ks[1], (DEPTH, D_MODEL), 0.02),
        'norm_ffn_g': 1.0 + nrm(ks[2], (DEPTH, D_MODEL), 0.02),
        'w_in': nrm(ks[3], (DEPTH, D_MODEL, N_COLS), D_MODEL ** -0.5),
        'b_gate': nrm(ks[4], (DEPTH, N_BRANCH * D_MODEL), 0.01),
        'lam_q1': nrm(ks[5], (DEPTH, DIFF_MAP_DIM), 0.1),
        'lam_k1': nrm(ks[6], (DEPTH, DIFF_MAP_DIM), 0.1),
        'lam_q2': nrm(ks[7], (DEPTH, DIFF_MAP_DIM), 0.1),
        'lam_k2': nrm(ks[8], (DEPTH, DIFF_MAP_DIM), 0.1),
        'subln_w': 1.0 + nrm(ks[9], (DEPTH, HEAD_DIM), 0.02),
        'w_branch': nrm(ks[10], (DEPTH, N_BRANCH, MIX_W, D_MODEL), MIX_W ** -0.5),
        'w_out': nrm(ks[11], (DEPTH, D_MODEL, D_MODEL), D_MODEL ** -0.5 * out_sc),
        'w_ffn_gate': nrm(ks[12], (DEPTH, D_MODEL, D_FF), D_MODEL ** -0.5),
        'w_ffn_up': nrm(ks[13], (DEPTH, D_MODEL, D_FF), D_MODEL ** -0.5),
        'w_ffn_down': nrm(ks[14], (DEPTH, D_FF, D_MODEL), D_FF ** -0.5 * out_sc),
        'final_norm_g': 1.0 + nrm(ks[15], (D_MODEL,), 0.02),
    }


def reference(x, norm_mix_g, norm_ffn_g, w_in, b_gate, lam_q1, lam_k1, lam_q2, lam_k2, subln_w,
              w_branch, w_out, w_ffn_gate, w_ffn_up, w_ffn_down, final_norm_g):
    for l in range(DEPTH):
        lambda_init = 0.8 - 0.6 * math.exp(-0.3 * l)
        h = rms_norm(x, norm_mix_g[l])
        x = x + hybrid_mixer(h, w_in[l], b_gate[l], lam_q1[l], lam_k1[l], lam_q2[l], lam_k2[l],
                             subln_w[l], w_branch[l], w_out[l], lambda_init)
        h = rms_norm(x, norm_ffn_g[l])
        x = x + swiglu(h, w_ffn_gate[l], w_ffn_up[l], w_ffn_down[l])
    return rms_norm(x, final_norm_g)
```

```cpp
#include <hip/hip_runtime.h>
#include <cstdio>
#include <cstdint>
#include <cmath>
#define ONE_LAUNCH 0
namespace pg8 {
#define PG8_LAS __attribute__((address_space(3)))
typedef unsigned short bf16_t;
typedef short bf16x8 __attribute__((ext_vector_type(8)));
typedef float f32x4 __attribute__((ext_vector_type(4)));
typedef float f32x2 __attribute__((ext_vector_type(2)));
typedef unsigned u32x4 __attribute__((ext_vector_type(4)));
typedef unsigned u32x2 __attribute__((ext_vector_type(2)));
constexpr int BM = 256, BK = 64, HALF = 128, HTB = HALF * BK * 2  , STAGE_BYTES = 8 * HTB, NXCD = 8, WGM = 8;

__host__ __device__ __forceinline__ int lds_byte(int r, int c) { const int st = (r >> 4) * 2 + (c >> 5), rr = r & 15, cc = c & 31, ob = rr * 64 + cc * 2; return st * 1024 + (ob ^ (((ob >> 9) & 1) << 5)); }
__host__ __device__ __forceinline__ void stage_rc(int b, int& R, int& C) { const int st = b / 1024, sb = b % 1024, swz = sb ^ (((sb >> 9) & 1) << 5); R = (st >> 1) * 16 + swz / 64; C = (st & 1) * 32 + (swz % 64) / 2; }
__host__ __device__ __forceinline__ int perm32(int rho) { const int n = rho >> 4, i = rho & 15; return 8 * (i >> 2) + 4 * n + (i & 3); }

struct Unit { int pm, pn, seg; };
struct Gemm { const bf16_t* A; const bf16_t* Bt; int lda, ldb, K; long a_seg, b_seg; };

struct StaticOrder {
    int nM, nN, nwg, G, c, nseg;
    __host__ __device__ void init(int M, int N, int G_, int c_, int nseg_ = 1) { nM = M / BM; nN = N / BM; nwg = nM * nN; G = G_; c = c_; nseg = nseg_; }
    __host__ __device__ bool next(int i, Unit& u) const {
        const int it = i / nseg; u.seg = i - it * nseg;
        const long L = (long)it * G + c; if (L >= nwg) return false;
        int wgid = (int)L; { const int q = nwg / NXCD, r = nwg % NXCD, xcd = wgid % NXCD, off = wgid / NXCD; wgid = (xcd < r ? xcd * (q + 1) : r * (q + 1) + (xcd - r) * q) + off; }
        const int nig = WGM * nN, gid = wgid / nig, fm = gid * WGM, gsz = (nM - fm) < WGM ? (nM - fm) : WGM;
        u.pm = fm + ((wgid % nig) % gsz); u.pn = (wgid % nig) / gsz; return true;
    }
};

__device__ __forceinline__ unsigned cvt_pk_bf16(float lo, float hi) { unsigned r; asm volatile("v_cvt_pk_bf16_f32 %0, %1, %2" : "=v"(r) : "v"(lo), "v"(hi)); return r; }
__device__ __forceinline__ float bf_lo(unsigned w) { return __uint_as_float(w << 16); }
__device__ __forceinline__ float bf_hi(unsigned w) { return __uint_as_float(w & 0xffff0000u); }


template <class Epi, class Sched>
__device__ __forceinline__ void gemm_phase(PG8_LAS unsigned char* lds, const Gemm g, const Sched& S, const Epi& E) {
    int tid_ = threadIdx.x; asm volatile("" : "+v"(tid_));
    const int tid = tid_, wid = __builtin_amdgcn_readfirstlane(tid >> 6), lane = tid & 63, wr = wid >> 2, wc = wid & 3, fr = lane & 15, fq = lane >> 4;
    const int K = g.K, nt = K / BK;
    unsigned voffA[2], voffB[2];
#pragma unroll
    for (int i = 0; i < 2; ++i) { int R, C; stage_rc(tid * 16 + i * 8192, R, C); const int Rb = Epi::PERM ? ((R & ~31) + perm32(R & 31)) : R;
        voffA[i] = (unsigned)(R * g.lda + C) * 2u; voffB[i] = (unsigned)(Rb * g.ldb + C) * 2u; }
    const size_t kstep = (size_t)(BK * 2);
    const size_t hstepA = (size_t)HALF * g.lda * 2, hstepB = (size_t)HALF * g.ldb * 2;
    const size_t tstepA = 2 * hstepA, tstepB = 2 * hstepB;
    const unsigned ldsw = (unsigned)wid * 1024u;
    const int aoff = lds_byte(wr * 64 + fr, fq * 8), boff = lds_byte(wc * 32 + fr, fq * 8);
#define PG8_SA(b, h) (((b) * 2 + (h)) * HTB)
#define PG8_SB(b, h) ((4 + (b) * 2 + (h)) * HTB)
#define PG8_STAGE(bufoff, gbase, voff) do { _Pragma("unroll") for (int _i = 0; _i < 2; ++_i) \
        __builtin_amdgcn_global_load_lds((const unsigned*)((const char*)(gbase) + (voff)[_i]), (PG8_LAS unsigned*)(lds + (bufoff) + ldsw + _i * 8192), 16, 0, 0); } while (0)
#define PG8_LDA(dst, b, h) do { _Pragma("unroll") for (int m = 0; m < 4; ++m) _Pragma("unroll") for (int k = 0; k < 2; ++k) dst[m][k] = *(const PG8_LAS bf16x8*)(lds + PG8_SA(b, h) + aoff + m * 2048 + k * 1024); } while (0)
#define PG8_LDB(dst, b, h) do { _Pragma("unroll") for (int n = 0; n < 2; ++n) _Pragma("unroll") for (int k = 0; k < 2; ++k) dst[n][k] = *(const PG8_LAS bf16x8*)(lds + PG8_SB(b, h) + boff + n * 2048 + k * 1024); } while (0)
#define PG8_MMA(ai, bj, At, Bt) do { __builtin_amdgcn_s_setprio(1); _Pragma("unroll") for (int m = 0; m < 4; ++m) _Pragma("unroll") for (int n = 0; n < 2; ++n) _Pragma("unroll") for (int k = 0; k < 2; ++k) \
        acc[ai][bj][m][n] = __builtin_amdgcn_mfma_f32_16x16x32_bf16(Bt[n][k], At[m][k], acc[ai][bj][m][n], 0, 0, 0); __builtin_amdgcn_s_setprio(0); } while (0)
#define PG8_WAIT_V(n) asm volatile("s_waitcnt vmcnt(" #n ")" ::: "memory")
#define PG8_WAIT_L(n) asm volatile("s_waitcnt lgkmcnt(" #n ")" ::: "memory")
#define PG8_BAR __builtin_amdgcn_s_barrier()
#define PG8_SCHED __builtin_amdgcn_sched_barrier(0)
    Unit cur, nxt; int ui = 0;
    if (!S.next(0, cur)) return;
    f32x4 acc[2][2][4][2];
#pragma unroll
    for (int a = 0; a < 2; ++a)
#pragma unroll
        for (int b = 0; b < 2; ++b)
#pragma unroll
            for (int m = 0; m < 4; ++m)
#pragma unroll
                for (int n = 0; n < 2; ++n) acc[a][b][m][n] = (f32x4){0.f, 0.f, 0.f, 0.f};
    bf16x8 At[4][2], B0[2][2], B1[2][2];
    const char* cA = (const char*)g.A + (size_t)cur.pm * tstepA + (size_t)cur.seg * g.a_seg * 2; const char* cB = (const char*)g.Bt + (size_t)cur.pn * tstepB + (size_t)cur.seg * g.b_seg * 2;
    PG8_STAGE(PG8_SB(0, 0), cB, voffB); PG8_STAGE(PG8_SB(0, 1), cB + hstepB, voffB); PG8_STAGE(PG8_SA(0, 0), cA, voffA); PG8_STAGE(PG8_SA(0, 1), cA + hstepA, voffA);
    if (wr == 1) PG8_BAR;
    PG8_WAIT_V(2); PG8_BAR;
    PG8_STAGE(PG8_SB(1, 0), cB + kstep, voffB); PG8_STAGE(PG8_SA(1, 0), cA + kstep, voffA); PG8_STAGE(PG8_SB(1, 1), cB + hstepB + kstep, voffB);
    PG8_WAIT_V(6); PG8_BAR;
    for (;;) {
        const bool has_next = S.next(ui + 1, nxt);
        const char* nA = has_next ? (const char*)g.A + (size_t)nxt.pm * tstepA + (size_t)nxt.seg * g.a_seg * 2 : cA;
        const char* nB = has_next ? (const char*)g.Bt + (size_t)nxt.pn * tstepB + (size_t)nxt.seg * g.b_seg * 2 : cB;
        for (int t = 0; t < nt; t += 2) {
            const bool last = (t == nt - 2);
            const char* a1 = cA + (size_t)(t + 1) * kstep;
            const char* a2 = last ? nA : cA + (size_t)(t + 2) * kstep; const char* b2 = last ? nB : cB + (size_t)(t + 2) * kstep;
            const char* a3 = a2 + kstep; const char* b3 = b2 + kstep;
            PG8_LDB(B0, 0, 0); PG8_LDB(B1, 0, 1); PG8_SCHED; PG8_LDA(At, 0, 0); PG8_STAGE(PG8_SA(1, 1), a1 + hstepA, voffA);
            PG8_WAIT_V(8); PG8_WAIT_L(0); PG8_BAR; PG8_MMA(0, 0, At, B0); PG8_MMA(0, 1, At, B1); PG8_BAR; PG8_SCHED;
            PG8_LDA(At, 0, 1); PG8_STAGE(PG8_SB(0, 0), b2, voffB); PG8_STAGE(PG8_SB(0, 1), b2 + hstepB, voffB); PG8_STAGE(PG8_SA(0, 0), a2, voffA);
            PG8_WAIT_V(8); PG8_WAIT_L(0); PG8_BAR; PG8_MMA(1, 0, At, B0); PG8_MMA(1, 1, At, B1); PG8_BAR; PG8_SCHED;
            PG8_LDB(B0, 1, 0); PG8_LDB(B1, 1, 1); PG8_SCHED; PG8_LDA(At, 1, 0); PG8_STAGE(PG8_SA(0, 1), a2 + hstepA, voffA);
            PG8_WAIT_V(8); PG8_WAIT_L(0); PG8_BAR; PG8_MMA(0, 0, At, B0); PG8_MMA(0, 1, At, B1); PG8_BAR; PG8_SCHED;
            PG8_LDA(At, 1, 1); PG8_STAGE(PG8_SB(1, 0), b3, voffB); PG8_STAGE(PG8_SB(1, 1), b3 + hstepB, voffB); PG8_STAGE(PG8_SA(1, 0), a3, voffA);
            PG8_WAIT_V(8); PG8_WAIT_L(0); PG8_BAR; PG8_MMA(1, 0, At, B0); PG8_MMA(1, 1, At, B1); PG8_BAR; PG8_SCHED;
        }
        if (wr == 0) PG8_BAR;
        const bool zero = E(acc, cur, wr, wc, fr, fq);
        if (!has_next) break;
        if (zero) {
#pragma unroll
        for (int a = 0; a < 2; ++a)
#pragma unroll
            for (int b = 0; b < 2; ++b)
#pragma unroll
                for (int m = 0; m < 4; ++m)
#pragma unroll
                    for (int n = 0; n < 2; ++n) acc[a][b][m][n] = (f32x4){0.f, 0.f, 0.f, 0.f};
        }
        cur = nxt; cA = nA; cB = nB; ++ui;
        if (wr == 1) PG8_BAR;
    }
    PG8_WAIT_V(0);
    PG8_BAR;
#undef PG8_SA
#undef PG8_SB
#undef PG8_STAGE
#undef PG8_LDA
#undef PG8_LDB
#undef PG8_MMA
#undef PG8_WAIT_V
#undef PG8_WAIT_L
#undef PG8_BAR
#undef PG8_SCHED
}
}
constexpr int NWAVES = 8;
constexpr int BATCH = 8, SEQ = 2048, DM = 2048, DEPTH = 2, HD = 128, NH = 8, MIXW = 1024, DFF = 5632;
constexpr int M = BATCH * SEQ;
constexpr int NQKV = 9216, NG = 6144, NCOLS = NQKV + NG;
constexpr float RMS_EPS = 1e-6f;
constexpr int C_QA = 0, C_KA = 1024, C_VA = 2048, C_QB = 3072, C_KB = 4096, C_VB = 5120, C_QC = 6144, C_KC = 7168, C_VC = 8192;

constexpr size_t MiB = 1u << 20;
constexpr size_t WS_CTL = 0, CTL_ZERO_BYTES = 1 * MiB;
constexpr size_t CTL_SS = 65536;
constexpr size_t WS_W = 2 * MiB;
constexpr size_t W_IN = 0, W_BR = 60 * MiB, W_OUT = 72 * MiB, W_GU = 80 * MiB, W_DN = 124 * MiB, W_LAYER = 146 * MiB;
constexpr size_t WS_QKV = WS_W + 2 * W_LAYER;
constexpr size_t WS_MERGED = WS_QKV, WS_HID = WS_QKV + 64 * MiB;
constexpr size_t WS_G = WS_QKV + 288 * MiB;
constexpr size_t WS_BRX = WS_G + 192 * MiB;
constexpr size_t WS_END = WS_BRX + 96 * MiB;
constexpr int CW_BAR = 4096;

constexpr int RING_OFF = 0, RING_BYTES = 131072;
constexpr int LDSCTL_OFF = RING_BYTES, MISC_OFF = LDSCTL_OFF + 320;
constexpr int LDS_BYTES = 147456;

#define GAS __attribute__((address_space(1)))
#define LAS __attribute__((address_space(3)))
typedef unsigned short bf16;
typedef unsigned v4u __attribute__((ext_vector_type(4)));
typedef unsigned v2u __attribute__((ext_vector_type(2)));
typedef float f32x4 __attribute__((ext_vector_type(4)));
typedef short bf16x8 __attribute__((ext_vector_type(8)));
typedef GAS unsigned gu32;
#define RLX_AGENT __ATOMIC_RELAXED, __HIP_MEMORY_SCOPE_AGENT
#define LDS_WAIT() asm volatile("s_waitcnt lgkmcnt(0)" ::: "memory")
#define VM_WAIT() asm volatile("s_waitcnt vmcnt(0)" ::: "memory")
__device__ __forceinline__ unsigned f2bf(float f) { unsigned u = __builtin_bit_cast(unsigned, f); return (u + 0x7fffu + ((u >> 16) & 1u)) >> 16; }
__device__ __forceinline__ unsigned pk2(float lo, float hi) { return f2bf(lo) | (f2bf(hi) << 16); }
__device__ __forceinline__ float bf2f(bf16 b) { return __uint_as_float((unsigned)b << 16); }

#define XB_TMO      128
#define XB_XCNT(j)  (256  + 64 * (j))
#define XB_XSUB(j)  (1280 + 64 * (j))
#define XB_XGEN(j)  (2304 + 64 * (j))
#define XB_TOP      3328
#define XB_TOPGEN   3392
#define XCD_BAR_WORDS 3456
#define XB_SPIN_CAP (1u << 18)
__device__ __forceinline__ unsigned xb_ld(unsigned* p)              { return __hip_atomic_load(p, __ATOMIC_RELAXED, __HIP_MEMORY_SCOPE_AGENT); }
__device__ __forceinline__ unsigned xb_add(unsigned* p, unsigned v) { return __hip_atomic_fetch_add(p, v, __ATOMIC_RELAXED, __HIP_MEMORY_SCOPE_AGENT); }
__device__ __forceinline__ unsigned xb_xcc_id() { return (unsigned)__builtin_amdgcn_s_getreg((3 << 11) | 20) & 0xFu; }
#define XB_SPIN(cond, bar) do { unsigned _sp = 0; while (cond) { __builtin_amdgcn_s_sleep(1); \
    if ((++_sp & 255u) == 0u) { if (xb_ld(&(bar)[XB_TMO])) break; if (_sp > XB_SPIN_CAP) { atomicAdd(&(bar)[XB_TMO], 1u); break; } } } } while (0)
struct XcdBarrier { unsigned* bar; unsigned x; volatile LAS unsigned* st; };
__device__ __forceinline__ XcdBarrier xcd_barrier_post(unsigned* bar, volatile LAS unsigned* st) {
    XcdBarrier b; b.bar = bar; b.x = xb_xcc_id(); b.st = st;
    if (threadIdx.x == 0) (void)xb_add(&bar[XB_XCNT(b.x)], 1u);
    return b;
}
__device__ __forceinline__ void xcd_barrier_complete(unsigned* bar, unsigned x, unsigned& nloc, unsigned& nx) {
    const unsigned G = gridDim.x * gridDim.y * gridDim.z;
    unsigned sum, cnt, mine, sp = 0u;
    for (;;) {
        sum = 0u; cnt = 0u; mine = 0u;
#pragma unroll
        for (unsigned j = 0; j < 16; ++j) { const unsigned c = xb_ld(&bar[XB_XCNT(j)]); sum += c; cnt += (c > 0u) ? 1u : 0u; mine = (j == x) ? c : mine; }
        if (sum == G) break;
        __builtin_amdgcn_s_sleep(1);
        if ((++sp & 255u) == 0u) { if (xb_ld(&bar[XB_TMO])) break; if (sp > XB_SPIN_CAP) { atomicAdd(&bar[XB_TMO], 1u); break; } }
    }
    nloc = mine > 0u ? mine : 1u; nx = cnt > 0u ? cnt : 1u;
}
__device__ __forceinline__ void xcd_barrier(const XcdBarrier& b) {
    asm volatile("s_waitcnt vmcnt(0)" ::: "memory");
    __syncthreads();
    if (threadIdx.x == 0) {
        unsigned* bar = b.bar;
        __builtin_amdgcn_s_waitcnt(0);
        unsigned nloc = b.st[0], nx = b.st[1];
        if (nloc == 0u) { xcd_barrier_complete(bar, b.x, nloc, nx); b.st[0] = nloc; b.st[1] = nx; }
        const unsigned old = xb_add(&bar[XB_XSUB(b.x)], 1u);
        const unsigned gen = old / nloc;
        if (old + 1u == (gen + 1u) * nloc) {
            __builtin_amdgcn_fence(__ATOMIC_RELEASE, "agent");
            asm volatile("s_waitcnt vmcnt(0)" ::: "memory");
            const unsigned og = xb_add(&bar[XB_TOP], 1u);
            const unsigned tg = og / nx;
            if (og + 1u == (tg + 1u) * nx) xb_add(&bar[XB_TOPGEN], 1u);
            else XB_SPIN(xb_ld(&bar[XB_TOPGEN]) == tg, bar);
            __builtin_amdgcn_fence(__ATOMIC_ACQUIRE, "agent");
            xb_add(&bar[XB_XGEN(b.x)], 1u);
            asm volatile("s_waitcnt vmcnt(0)" ::: "memory");
        } else {
            XB_SPIN(xb_ld(&bar[XB_XGEN(b.x)]) == gen, bar);
            __builtin_amdgcn_fence(__ATOMIC_ACQUIRE, "agent");
            asm volatile("s_waitcnt vmcnt(0)" ::: "memory");
        }
    }
    __syncthreads();
}

namespace pg8 {
struct EpiProj {
    static constexpr bool PERM = true;
    bf16_t* QKV; bf16_t* G; const float* ss;
    __device__ __forceinline__ bool operator()(f32x4 (&acc)[2][2][4][2], const Unit& u, int wr, int wc, int fr, int fq) const {
        int colt = u.pn * BM; bf16_t* base = QKV; int ldc = NQKV;
        if (u.pn >= NQKV / BM) { base = G; ldc = NG; colt -= NQKV; }
        const int row0 = u.pm * BM + wr * 64 + fr, col0 = colt + wc * 32 + 8 * fq;
#pragma unroll
        for (int ai = 0; ai < 2; ++ai)
#pragma unroll
            for (int m = 0; m < 4; ++m) { const int row = row0 + ai * HALF + m * 16; const float rs = rsqrtf(ss[row] * (1.0f / DM) + RMS_EPS);
                bf16_t* rowp = base + (size_t)row * ldc + col0;
#pragma unroll
                for (int bj = 0; bj < 2; ++bj) { const f32x4 v0 = acc[ai][bj][m][0] * rs, v1 = acc[ai][bj][m][1] * rs;
                    u32x4 w; w.x = cvt_pk_bf16(v0[0], v0[1]); w.y = cvt_pk_bf16(v0[2], v0[3]); w.z = cvt_pk_bf16(v1[0], v1[1]); w.w = cvt_pk_bf16(v1[2], v1[3]);
                    *(u32x4*)(rowp + bj * HALF) = w; } }
        return true;
    }
};
struct EpiMerge {
    static constexpr bool PERM = true;
    const bf16_t* G; const float* bg; bf16_t* O;
    __device__ __forceinline__ bool operator()(f32x4 (&acc)[2][2][4][2], const Unit& u, int wr, int wc, int fr, int fq) const {
        const int s = u.seg; const int row0 = u.pm * BM + wr * 64 + fr, col0 = u.pn * BM + wc * 32 + 8 * fq;
#pragma unroll
        for (int bj = 0; bj < 2; ++bj) {
            const int col = col0 + bj * HALF;
            const f32x4 ba0 = *(const f32x4*)(bg + s * DM + col), ba1 = *(const f32x4*)(bg + s * DM + col + 4);
            f32x4 bb0 = (f32x4){0.f, 0.f, 0.f, 0.f}, bb1 = bb0;
            if (s < 2) { bb0 = *(const f32x4*)(bg + (s + 1) * DM + col); bb1 = *(const f32x4*)(bg + (s + 1) * DM + col + 4); }
#pragma unroll
            for (int ai = 0; ai < 2; ++ai)
#pragma unroll
                for (int m = 0; m < 4; ++m) { const int row = row0 + ai * HALF + m * 16;
                    const u32x4 ga = *(const u32x4*)(G + (size_t)row * NG + s * DM + col);
                    float a[8] = {bf_lo(ga.x) + ba0[0], bf_hi(ga.x) + ba0[1], bf_lo(ga.y) + ba0[2], bf_hi(ga.y) + ba0[3], bf_lo(ga.z) + ba1[0], bf_hi(ga.z) + ba1[1], bf_lo(ga.w) + ba1[2], bf_hi(ga.w) + ba1[3]};
                    float f[8];
                    if (s < 2) {
                        const u32x4 gb = *(const u32x4*)(G + (size_t)row * NG + (s + 1) * DM + col);
                        float b[8] = {bf_lo(gb.x) + bb0[0], bf_hi(gb.x) + bb0[1], bf_lo(gb.y) + bb0[2], bf_hi(gb.y) + bb0[3], bf_lo(gb.z) + bb1[0], bf_hi(gb.z) + bb1[1], bf_lo(gb.w) + bb1[2], bf_hi(gb.w) + bb1[3]};
#pragma unroll
                        for (int e = 0; e < 8; ++e) f[e] = (1.0f + __expf(-b[e])) / (1.0f + __expf(-a[e]));
                    } else {
#pragma unroll
                        for (int e = 0; e < 8; ++e) f[e] = 1.0f / (1.0f + __expf(-a[e]));
                    }
                    f32x4 v0 = acc[ai][bj][m][0], v1 = acc[ai][bj][m][1];
                    v0[0] *= f[0]; v0[1] *= f[1]; v0[2] *= f[2]; v0[3] *= f[3]; v1[0] *= f[4]; v1[1] *= f[5]; v1[2] *= f[6]; v1[3] *= f[7];
                    acc[ai][bj][m][0] = v0; acc[ai][bj][m][1] = v1;
                    if (s == 2) { u32x4 w; w.x = cvt_pk_bf16(v0[0], v0[1]); w.y = cvt_pk_bf16(v0[2], v0[3]); w.z = cvt_pk_bf16(v1[0], v1[1]); w.w = cvt_pk_bf16(v1[2], v1[3]);
                        *(u32x4*)(O + (size_t)row * DM + col) = w; } }
        }
        return s == 2;
    }
};
struct EpiResid {
    static constexpr bool PERM = false;
    const float* xin; float* xout; bf16_t* xb; float* ss;
    __device__ __forceinline__ bool operator()(f32x4 (&acc)[2][2][4][2], const Unit& u, int wr, int wc, int fr, int fq) const {
        const int col0 = u.pn * BM + wc * 32 + 4 * fq;
#pragma unroll
        for (int ai = 0; ai < 2; ++ai)
#pragma unroll
            for (int m = 0; m < 4; ++m) { const int row = u.pm * BM + ai * HALF + wr * 64 + m * 16 + fr; const size_t off = (size_t)row * DM + col0; float q = 0.f;
#pragma unroll
                for (int bj = 0; bj < 2; ++bj)
#pragma unroll
                    for (int n = 0; n < 2; ++n) { const f32x4 xv = *(const f32x4*)(xin + off + bj * HALF + n * 16); const f32x4 o = xv + acc[ai][bj][m][n];
                        *(f32x4*)(xout + off + bj * HALF + n * 16) = o; q += (o[0] * o[0] + o[1] * o[1]) + (o[2] * o[2] + o[3] * o[3]);
                        u32x2 w; w.x = cvt_pk_bf16(o[0], o[1]); w.y = cvt_pk_bf16(o[2], o[3]); *(u32x2*)(xb + off + bj * HALF + n * 16) = w; }
                q += __shfl_xor(q, 16); q += __shfl_xor(q, 32);
                if (fq == 0) atomicAdd(ss + row, q); }
        return true;
    }
};
struct EpiSwiGLU {
    static constexpr bool PERM = true;
    bf16_t* H; const float* ss;
    __device__ __forceinline__ bool operator()(f32x4 (&acc)[2][2][4][2], const Unit& u, int wr, int wc, int fr, int fq) const {
        const int row0 = u.pm * BM + wr * 64 + fr, col0 = u.pn * HALF + wc * 32 + 8 * fq;
#pragma unroll
        for (int ai = 0; ai < 2; ++ai)
#pragma unroll
            for (int m = 0; m < 4; ++m) { const int row = row0 + ai * HALF + m * 16; const float rs = rsqrtf(ss[row] * (1.0f / DM) + RMS_EPS);
                float h[8];
#pragma unroll
                for (int n = 0; n < 2; ++n)
#pragma unroll
                    for (int e = 0; e < 4; ++e) { const float gv = acc[ai][0][m][n][e] * rs, uv = acc[ai][1][m][n][e] * rs; h[n * 4 + e] = gv / (1.0f + __expf(-gv)) * uv; }
                u32x4 w; w.x = cvt_pk_bf16(h[0], h[1]); w.y = cvt_pk_bf16(h[2], h[3]); w.z = cvt_pk_bf16(h[4], h[5]); w.w = cvt_pk_bf16(h[6], h[7]);
                *(u32x4*)(H + (size_t)row * DFF + col0) = w; }
        return true;
    }
};
}

struct Frame {
    LAS unsigned char* lds;
    volatile LAS unsigned* MISC;
    gu32* ctl;
    int tid, lane, wave;
    int vcu, G;
};
__device__ __forceinline__ float wave_sum(float v) {
#pragma unroll
    for (int o = 1; o < 64; o <<= 1) v += __shfl_xor(v, o);
    return v;
}
template <int MODE>
__device__ __forceinline__ void p0_transpose_item(const float* W, int K, int N, bf16* WT, int row_off, const float* gain, LAS float* scr, int item, int lane) {
    const int nblk = N / 32, kb = item / nblk, nb = item % nblk, k0 = 64 * kb, n0 = 32 * nb;
#pragma unroll 8
    for (int i = 0; i < 32; ++i) { const int kk = 2 * i + (lane >> 5); float v = W[(size_t)(k0 + kk) * N + n0 + (lane & 31)]; if (gain) v *= gain[k0 + kk]; scr[kk * 33 + (lane & 31)] = v; }
    LDS_WAIT(); asm volatile("" ::: "memory");
    const int c = lane & 7;
#pragma unroll
    for (int j = 0; j < 4; ++j) { const int n = (lane >> 3) + 8 * j; const LAS float* s = scr + (8 * c) * 33 + n;
        v4u o; o.x = pk2(s[0 * 33], s[1 * 33]); o.y = pk2(s[2 * 33], s[3 * 33]); o.z = pk2(s[4 * 33], s[5 * 33]); o.w = pk2(s[6 * 33], s[7 * 33]);
        const int nn = n0 + n; const int dr = (MODE == 0) ? (row_off + nn) : ((nn >> 7) * 256 + (nn & 127) + (MODE == 2 ? 128 : 0));
        *(GAS v4u*)(WT + (size_t)dr * K + k0 + 8 * c) = o; }
    LDS_WAIT(); asm volatile("" ::: "memory");
}
template <int MODE>
__global__ void __launch_bounds__(128) naive_attn(const bf16* __restrict__ QKV, bf16* __restrict__ BR, const float* lq1, const float* lk1, const float* lq2, const float* lk2,
                                                  const float* subln, float lambda_init) {
    __shared__ float sbuf[2][2][SEQ];
    __shared__ float qs[2][HD];
    const int w = threadIdx.x >> 6, lane = threadIdx.x & 63;
    const int rid = blockIdx.x * 2 + w; const int t = rid % SEQ, h = (rid / SEQ) % NH, b = rid / (SEQ * NH);
    const int qcol = (MODE == 0 ? C_QA : MODE == 1 ? C_QB : C_QC) + h * HD, kcol = (MODE == 0 ? C_KA : MODE == 1 ? C_KB : C_KC) + h * HD, vcol = (MODE == 0 ? C_VA : MODE == 1 ? C_VB : C_VC) + h * HD;
    const bf16* base = QKV + (size_t)b * SEQ * NQKV;
    { const unsigned qq = *(const unsigned*)(base + (size_t)t * NQKV + qcol + 2 * lane); qs[w][2 * lane] = __uint_as_float(qq << 16); qs[w][2 * lane + 1] = __uint_as_float(qq & 0xffff0000u); }
    __syncthreads();
    float* s0 = sbuf[w][0]; float* s1 = sbuf[w][1];
    for (int j = lane; j <= t; j += 64) {
        const v4u* kr = (const v4u*)(base + (size_t)j * NQKV + kcol); float a0 = 0.f, a1 = 0.f;
#pragma unroll 4
        for (int c = 0; c < 16; ++c) { const v4u kv = kr[c]; const float* q = &qs[w][c * 8]; float d = 0.f;
            d += __uint_as_float(kv.x << 16) * q[0] + __uint_as_float(kv.x & 0xffff0000u) * q[1];
            d += __uint_as_float(kv.y << 16) * q[2] + __uint_as_float(kv.y & 0xffff0000u) * q[3];
            d += __uint_as_float(kv.z << 16) * q[4] + __uint_as_float(kv.z & 0xffff0000u) * q[5];
            d += __uint_as_float(kv.w << 16) * q[6] + __uint_as_float(kv.w & 0xffff0000u) * q[7];
            if (c < 8) a0 += d; else a1 += d; }
        if (MODE == 0) { s0[j] = a0; s1[j] = a1; } else { s0[j] = a0 + a1; }
    }
    __syncthreads();
    if (MODE == 0) {
        const float lam = __expf(wave_sum(lq1[lane] * lk1[lane])) - __expf(wave_sum(lq2[lane] * lk2[lane])) + lambda_init;
        const float slope = exp2f(-(float)(2 * h + 1) * 0.5f);
        float mx0 = -INFINITY, mx1 = -INFINITY;
        for (int j = lane; j <= t; j += 64) { const float bias = slope * (float)(t - j); const float c0 = s0[j] * 0.125f - bias, c1 = s1[j] * 0.125f - bias; s0[j] = c0; s1[j] = c1; mx0 = fmaxf(mx0, c0); mx1 = fmaxf(mx1, c1); }
#pragma unroll
        for (int o = 1; o < 64; o <<= 1) { mx0 = fmaxf(mx0, __shfl_xor(mx0, o)); mx1 = fmaxf(mx1, __shfl_xor(mx1, o)); }
        float l0 = 0.f, l1 = 0.f;
        for (int j = lane; j <= t; j += 64) { const float p0 = __expf(s0[j] - mx0), p1 = __expf(s1[j] - mx1); s0[j] = p0; s1[j] = p1; l0 += p0; l1 += p1; }
        l0 = wave_sum(l0); l1 = wave_sum(l1);
        const float r0 = 1.0f / l0, r1 = lam / l1;
        for (int j = lane; j <= t; j += 64) s0[j] = s0[j] * r0 - s1[j] * r1;
    } else if (MODE == 1) {
        const float scale = 0.08838834764831845f; float carry = 0.f;
        for (int c = (t > 0 ? (t - 1) >> 6 : -1); c >= 0; --c) {
            const int j = c * 64 + lane; const bool ok = j < t;
            const float z = ok ? s0[j] * scale : 0.f;
            const float sp = fmaxf(z, 0.f) + log1pf(__expf(-fabsf(z)));
            const float lf = ok ? -sp : 0.f;
            float sc = lf;
#pragma unroll
            for (int o = 1; o < 64; o <<= 1) { const float v = __shfl_down(sc, o); if (lane + o < 64) sc += v; }
            const float suffix = carry + sc - lf;
            if (ok) s0[j] = __expf((z - sp) + suffix);
            carry += __shfl(sc, 0);
        }
        if (lane == 0) s0[t] = 0.f;
    } else {
        const float scale = 0.08838834764831845f; const float slope = exp2f(-(float)(h + 1)); const int own = t >> 8;
        float gate[8]; unsigned sel = 0u;
#pragma unroll
        for (int n = 0; n < 8; ++n) { float g = 0.f; if (n < own) { g = s0[n * 256 + lane] + s0[n * 256 + 64 + lane] + s0[n * 256 + 128 + lane] + s0[n * 256 + 192 + lane]; g = wave_sum(g); } gate[n] = g; }
        const int npick = own < 3 ? own : 3;
        for (int r = 0; r < npick; ++r) { int best = -1; float bv = -INFINITY;
#pragma unroll
            for (int n = 0; n < 8; ++n) if (n < own && !((sel >> n) & 1u) && (best < 0 || gate[n] > bv)) { best = n; bv = gate[n]; }
            sel |= 1u << best; }
        float mx = -INFINITY;
        for (int j = lane; j <= t; j += 64) { const int blk = j >> 8; const bool ok = (blk == own) || ((sel >> blk) & 1u);
            const float c0 = ok ? s0[j] * scale - slope * (float)(t - j) : -INFINITY; s0[j] = c0; mx = fmaxf(mx, c0); }
#pragma unroll
        for (int o = 1; o < 64; o <<= 1) mx = fmaxf(mx, __shfl_xor(mx, o));
        float l = 0.f;
        for (int j = lane; j <= t; j += 64) { const float p = __expf(s0[j] - mx); s0[j] = p; l += p; }
        l = wave_sum(l); const float r = 1.0f / l;
        for (int j = lane; j <= t; j += 64) s0[j] *= r;
    }
    __syncthreads();
    float o0 = 0.f, o1 = 0.f;
    for (int j = 0; j <= t; ++j) { const float wgt = s0[j]; const unsigned vv = *(const unsigned*)(base + (size_t)j * NQKV + vcol + 2 * lane);
        o0 += wgt * __uint_as_float(vv << 16); o1 += wgt * __uint_as_float(vv & 0xffff0000u); }
    if (MODE == 0) {
        const float ms = wave_sum(o0 * o0 + o1 * o1) * (1.0f / HD); const float r = rsqrtf(ms + RMS_EPS) * (1.0f - lambda_init);
        o0 = o0 * r * subln[2 * lane]; o1 = o1 * r * subln[2 * lane + 1];
    }
    *(unsigned*)(BR + (size_t)(b * SEQ + t) * (3 * MIXW) + MODE * MIXW + h * HD + 2 * lane) = pk2(o0, o1);
}
struct Args { const float* in[16]; float* out; unsigned char* ws; int ph_lo, ph_hi; };
constexpr int N_PHASES = 14;

__device__ __forceinline__ void p0_prologue(Frame& F, const Args& a) {
    LAS float* scr = (LAS float*)(F.lds + RING_OFF + F.wave * 16384);
    const int gw = F.vcu * NWAVES + F.wave, NGW = F.G * NWAVES;
    constexpr int I_IN = (DM / 64) * (NCOLS / 32), I_BR = (MIXW / 64) * (DM / 32), I_OUT = (DM / 64) * (DM / 32), I_GU = (DM / 64) * (DFF / 32), I_DN = (DFF / 64) * (DM / 32);
    constexpr int I_LAYER = I_IN + 3 * I_BR + I_OUT + 2 * I_GU + I_DN;
    for (int it = gw; it < DEPTH * I_LAYER; it += NGW) {
        const int l = it / I_LAYER; int r = it - l * I_LAYER;
        unsigned char* wl = a.ws + WS_W + (size_t)l * W_LAYER;
        if (r < I_IN) { p0_transpose_item<0>(a.in[3] + (size_t)l * DM * NCOLS, DM, NCOLS, (bf16*)(wl + W_IN), 0, a.in[1] + l * DM, scr, r, F.lane); continue; } r -= I_IN;
        if (r < 3 * I_BR) { const int i = r / I_BR; r -= i * I_BR;
            p0_transpose_item<0>(a.in[10] + ((size_t)l * 3 + i) * MIXW * DM, MIXW, DM, (bf16*)(wl + W_BR) + (size_t)i * DM * MIXW, 0, nullptr, scr, r, F.lane); continue; } r -= 3 * I_BR;
        if (r < I_OUT) { p0_transpose_item<0>(a.in[11] + (size_t)l * DM * DM, DM, DM, (bf16*)(wl + W_OUT), 0, nullptr, scr, r, F.lane); continue; } r -= I_OUT;
        if (r < I_GU) { p0_transpose_item<1>(a.in[12] + (size_t)l * DM * DFF, DM, DFF, (bf16*)(wl + W_GU), 0, a.in[2] + l * DM, scr, r, F.lane); continue; } r -= I_GU;
        if (r < I_GU) { p0_transpose_item<2>(a.in[13] + (size_t)l * DM * DFF, DM, DFF, (bf16*)(wl + W_GU), 0, a.in[2] + l * DM, scr, r, F.lane); continue; } r -= I_GU;
        p0_transpose_item<0>(a.in[14] + (size_t)l * DFF * DM, DFF, DM, (bf16*)(wl + W_DN), 0, nullptr, scr, r, F.lane);
    }
    bf16* xb = (bf16*)(a.ws + WS_BRX); float* ss0 = (float*)(a.ws + CTL_SS);
    for (int m = gw; m < M; m += NGW) {
        const GAS f32x4* xr = (const GAS f32x4*)(a.in[0] + (size_t)m * DM) + F.lane; GAS v2u* o8 = (GAS v2u*)(xb + (size_t)m * DM) + F.lane; float s = 0.f;
#pragma unroll
        for (int j = 0; j < 8; ++j) { const f32x4 v = xr[64 * j]; s += (v.x * v.x + v.y * v.y) + (v.z * v.z + v.w * v.w); v2u o; o.x = pk2(v.x, v.y); o.y = pk2(v.z, v.w); o8[64 * j] = o; }
        s = wave_sum(s); if (F.lane == 0) ss0[m] = s;
    }
}
__device__ __forceinline__ void p_final_norm(Frame& F, const Args& a) {
    const int gw = F.vcu * NWAVES + F.wave, NGW = F.G * NWAVES; const float* ss = (const float*)(a.ws + CTL_SS) + 4 * M; const float* g = a.in[15];
    for (int m = gw; m < M; m += NGW) {
        GAS f32x4* xr = (GAS f32x4*)(a.out + (size_t)m * DM) + F.lane; const float rs = rsqrtf(ss[m] * (1.0f / DM) + RMS_EPS);
#pragma unroll
        for (int j = 0; j < 8; ++j) { const f32x4 v = xr[64 * j]; const f32x4 gv = *((const f32x4*)g + F.lane + 64 * j); xr[64 * j] = v * rs * gv; }
    }
}

__global__ void __launch_bounds__(NWAVES * 64, 2) fwd(Args args) {
    extern __shared__ __attribute__((aligned(16))) unsigned char lds[];
    Frame F;
    F.lds = (LAS unsigned char*)lds;
    F.MISC = (volatile LAS unsigned*)(F.lds + MISC_OFF);
    F.tid = threadIdx.x; F.lane = F.tid & 63; F.wave = __builtin_amdgcn_readfirstlane(F.tid >> 6);
    F.G = gridDim.x; { const int bx = blockIdx.x; F.vcu = (F.G % 8 == 0) ? (bx % 8) * (F.G / 8) + bx / 8 : bx; }
    unsigned char* ws = args.ws;
    F.ctl = (gu32*)(ws + WS_CTL);
    for (int u = F.tid; u < (LDS_BYTES - LDSCTL_OFF) / 4; u += NWAVES * 64) ((LAS unsigned*)(F.lds + LDSCTL_OFF))[u] = 0u;
    __syncthreads();
    const int lo = args.ph_lo, hi = args.ph_hi;
    XcdBarrier bar; bar.bar = (unsigned*)(F.ctl + CW_BAR); bar.x = 0; bar.st = nullptr;
    if (hi - lo > 1) bar = xcd_barrier_post((unsigned*)(F.ctl + CW_BAR), F.MISC + 8);
#ifndef PH_MASK
#define PH_MASK 0x3f
#endif
#define IN(k) (lo <= (k) && (k) < hi)
#define EN(j) ((PH_MASK >> (j)) & 1)
#define SEAM(k) do { if (IN(k) && IN((k) + 1)) xcd_barrier(bar); } while (0)
    float* ssb = (float*)(ws + CTL_SS);
    bf16* QKV = (bf16*)(ws + WS_QKV); bf16* GB = (bf16*)(ws + WS_G); bf16* BR = (bf16*)(ws + WS_BRX); bf16* XB = (bf16*)(ws + WS_BRX);
    bf16* MERGED = (bf16*)(ws + WS_MERGED); bf16* HID = (bf16*)(ws + WS_HID);

    if (IN(0)) { p0_prologue(F, args); SEAM(0); }
    for (int l = 0; l < DEPTH; ++l) {
        const int pb = 1 + 6 * l;
        unsigned char* wl = ws + WS_W + (size_t)l * W_LAYER;
        if (EN(0) && IN(pb + 0)) {
            pg8::Gemm g{XB, (const bf16*)(wl + W_IN), DM, DM, DM, 0, 0}; pg8::StaticOrder S; S.init(M, NCOLS, F.G, (int)blockIdx.x);
            pg8::EpiProj E{QKV, GB, ssb + (size_t)(2 * l) * M};
            pg8::gemm_phase<pg8::EpiProj, pg8::StaticOrder>(F.lds + RING_OFF, g, S, E);
            SEAM(pb + 0);
        }
        if (IN(pb + 1)) {
            SEAM(pb + 1);
        }
        if (EN(2) && IN(pb + 2)) {
            pg8::Gemm g{BR, (const bf16*)(wl + W_BR), 3 * MIXW, MIXW, MIXW, MIXW, (long)DM * MIXW}; pg8::StaticOrder S; S.init(M, DM, F.G, (int)blockIdx.x, 3);
            pg8::EpiMerge E{GB, args.in[4] + (size_t)l * NG, MERGED};
            pg8::gemm_phase<pg8::EpiMerge, pg8::StaticOrder>(F.lds + RING_OFF, g, S, E);
            SEAM(pb + 2);
        }
        if (EN(3) && IN(pb + 3)) {
            pg8::Gemm g{MERGED, (const bf16*)(wl + W_OUT), DM, DM, DM, 0, 0}; pg8::StaticOrder S; S.init(M, DM, F.G, (int)blockIdx.x);
            pg8::EpiResid E{l == 0 ? args.in[0] : args.out, args.out, XB, ssb + (size_t)(2 * l + 1) * M};
            pg8::gemm_phase<pg8::EpiResid, pg8::StaticOrder>(F.lds + RING_OFF, g, S, E);
            SEAM(pb + 3);
        }
        if (EN(4) && IN(pb + 4)) {
            pg8::Gemm g{XB, (const bf16*)(wl + W_GU), DM, DM, DM, 0, 0}; pg8::StaticOrder S; S.init(M, 2 * DFF, F.G, (int)blockIdx.x);
            pg8::EpiSwiGLU E{HID, ssb + (size_t)(2 * l + 1) * M};
            pg8::gemm_phase<pg8::EpiSwiGLU, pg8::StaticOrder>(F.lds + RING_OFF, g, S, E);
            SEAM(pb + 4);
        }
        if (EN(5) && IN(pb + 5)) {
            pg8::Gemm g{HID, (const bf16*)(wl + W_DN), DFF, DFF, DFF, 0, 0}; pg8::StaticOrder S; S.init(M, DM, F.G, (int)blockIdx.x);
            pg8::EpiResid E{args.out, args.out, XB, ssb + (size_t)(2 * l + 2) * M};
            pg8::gemm_phase<pg8::EpiResid, pg8::StaticOrder>(F.lds + RING_OFF, g, S, E);
            SEAM(pb + 5);
        }
    }
    if (IN(13)) p_final_norm(F, args);
#undef IN
#undef SEAM
}

extern "C" void kernel_launch(void* const* d_in, const int* in_sizes, int n_in, void* d_out, int out_size, void* d_ws, size_t ws_size, hipStream_t stream) {
    static int grid = 0;
    if (grid == 0) {
        if (n_in != 16 || out_size != M * DM || ws_size < WS_END) { fprintf(stderr, "kernel_launch: unexpected shapes (n_in %d out %d ws %zu)\n", n_in, out_size, ws_size); grid = -1; return; }
        int dev = 0, cus = 0, per_cu = 0;
        if (hipGetDevice(&dev) != hipSuccess || hipDeviceGetAttribute(&cus, hipDeviceAttributeMultiprocessorCount, dev) != hipSuccess) { grid = -1; return; }
        if (hipFuncSetAttribute((const void*)fwd, hipFuncAttributeMaxDynamicSharedMemorySize, LDS_BYTES) != hipSuccess) { grid = -1; return; }
        if (hipOccupancyMaxActiveBlocksPerMultiprocessor(&per_cu, (const void*)fwd, NWAVES * 64, LDS_BYTES) != hipSuccess || per_cu < 1) { fprintf(stderr, "occupancy query: %d\n", per_cu); }
        (void)hipGetLastError();
        grid = cus;
    }
    if (grid < 0) return;
    (void)hipMemsetAsync((char*)d_ws + WS_CTL, 0, CTL_ZERO_BYTES, stream);
    Args a{};
    for (int i = 0; i < 16; ++i) a.in[i] = (const float*)d_in[i];
    a.out = (float*)d_out; a.ws = (unsigned char*)d_ws;
#if ONE_LAUNCH
    a.ph_lo = 0; a.ph_hi = N_PHASES;
    hipLaunchKernelGGL(fwd, dim3(grid), dim3(NWAVES * 64), LDS_BYTES, stream, a);
#else
    for (int p = 0; p < N_PHASES; ++p) {
        const int rel = (p >= 1 && p <= 12) ? (p - 1) % 6 : -1; const int l = (p - 1) / 6;
        if (rel == 1) {
            const bf16* QKV = (const bf16*)((unsigned char*)d_ws + WS_QKV); bf16* BR = (bf16*)((unsigned char*)d_ws + WS_BRX);
            const float li = 0.8f - 0.6f * expf(-0.3f * (float)l);
            const float *q1 = a.in[5] + l * 64, *k1 = a.in[6] + l * 64, *q2 = a.in[7] + l * 64, *k2 = a.in[8] + l * 64, *sw = a.in[9] + l * HD;
            const int nb = BATCH * NH * SEQ / 2;
            hipLaunchKernelGGL(naive_attn<0>, dim3(nb), dim3(128), 0, stream, QKV, BR, q1, k1, q2, k2, sw, li);
            hipLaunchKernelGGL(naive_attn<1>, dim3(nb), dim3(128), 0, stream, QKV, BR, q1, k1, q2, k2, sw, li);
            hipLaunchKernelGGL(naive_attn<2>, dim3(nb), dim3(128), 0, stream, QKV, BR, q1, k1, q2, k2, sw, li);
            continue;
        }
        a.ph_lo = p; a.ph_hi = p + 1;
        hipLaunchKernelGGL(fwd, dim3(grid), dim3(NWAVES * 64), LDS_BYTES, stream, a);
    }
#endif
}
```

```cpp
#include <hip/hip_runtime.h>
#include <cstdio>
#include <cstdint>
#include <cmath>
#define ONE_LAUNCH 1
#define NAIVE_ATTN 0
namespace pg8 {
#define PG8_LAS __attribute__((address_space(3)))
typedef unsigned short bf16_t;
typedef short bf16x8 __attribute__((ext_vector_type(8)));
typedef float f32x4 __attribute__((ext_vector_type(4)));
typedef float f32x2 __attribute__((ext_vector_type(2)));
typedef unsigned u32x4 __attribute__((ext_vector_type(4)));
typedef unsigned u32x2 __attribute__((ext_vector_type(2)));
constexpr int BM = 256, BK = 64, HALF = 128, HTB = HALF * BK * 2  , STAGE_BYTES = 8 * HTB, NXCD = 8, WGM = 8;

__host__ __device__ __forceinline__ int lds_byte(int r, int c) { const int st = (r >> 4) * 2 + (c >> 5), rr = r & 15, cc = c & 31, ob = rr * 64 + cc * 2; return st * 1024 + (ob ^ (((ob >> 9) & 1) << 5)); }
__host__ __device__ __forceinline__ void stage_rc(int b, int& R, int& C) { const int st = b / 1024, sb = b % 1024, swz = sb ^ (((sb >> 9) & 1) << 5); R = (st >> 1) * 16 + swz / 64; C = (st & 1) * 32 + (swz % 64) / 2; }
__host__ __device__ __forceinline__ int perm32(int rho) { const int n = rho >> 4, i = rho & 15; return 8 * (i >> 2) + 4 * n + (i & 3); }

struct Unit { int pm, pn, seg; };
struct Gemm { const bf16_t* A; const bf16_t* Bt; int lda, ldb, K; long a_seg, b_seg; };

struct StaticOrder {
    int nM, nN, nwg, G, c, nseg;
    __host__ __device__ void init(int M, int N, int G_, int c_, int nseg_ = 1) { nM = M / BM; nN = N / BM; nwg = nM * nN; G = G_; c = c_; nseg = nseg_; }
    __host__ __device__ bool next(int i, Unit& u) const {
        const int it = i / nseg; u.seg = i - it * nseg;
        const long L = (long)it * G + c; if (L >= nwg) return false;
        int wgid = (int)L; { const int q = nwg / NXCD, r = nwg % NXCD, xcd = wgid % NXCD, off = wgid / NXCD; wgid = (xcd < r ? xcd * (q + 1) : r * (q + 1) + (xcd - r) * q) + off; }
        const int nig = WGM * nN, gid = wgid / nig, fm = gid * WGM, gsz = (nM - fm) < WGM ? (nM - fm) : WGM;
        u.pm = fm + ((wgid % nig) % gsz); u.pn = (wgid % nig) / gsz; return true;
    }
};

typedef __bf16 bf16x2_t __attribute__((ext_vector_type(2)));
__device__ __forceinline__ unsigned cvt_pk_bf16(float lo, float hi) { f32x2 v = {lo, hi}; bf16x2_t b = __builtin_convertvector(v, bf16x2_t); return __builtin_bit_cast(unsigned, b); }
__device__ __forceinline__ float bf_lo(unsigned w) { return __uint_as_float(w << 16); }
__device__ __forceinline__ float bf_hi(unsigned w) { return __uint_as_float(w & 0xffff0000u); }


template <class Epi, class Sched>
__device__ __forceinline__ void gemm_phase(PG8_LAS unsigned char* lds, const Gemm g, const Sched& S, const Epi& E) {
    int tid_ = threadIdx.x; asm volatile("" : "+v"(tid_));
    const int tid = tid_, wid = __builtin_amdgcn_readfirstlane(tid >> 6), lane = tid & 63, wr = wid >> 2, wc = wid & 3, fr = lane & 15, fq = lane >> 4;
    const int K = g.K, nt = K / BK;
    unsigned voffA[2], voffB[2];
#pragma unroll
    for (int i = 0; i < 2; ++i) { int R, C; stage_rc(tid * 16 + i * 8192, R, C); const int Rb = Epi::PERM ? ((R & ~31) + perm32(R & 31)) : R;
        voffA[i] = (unsigned)(R * g.lda + C) * 2u; voffB[i] = (unsigned)(Rb * g.ldb + C) * 2u; }
    const size_t kstep = (size_t)(BK * 2);
    const size_t hstepA = (size_t)HALF * g.lda * 2, hstepB = (size_t)HALF * g.ldb * 2;
    const size_t tstepA = 2 * hstepA, tstepB = 2 * hstepB;
    const unsigned ldsw = (unsigned)wid * 1024u;
    const int aoff = lds_byte(wr * 64 + fr, fq * 8), boff = lds_byte(wc * 32 + fr, fq * 8);
#define PG8_SA(b, h) (((b) * 2 + (h)) * HTB)
#define PG8_SB(b, h) ((4 + (b) * 2 + (h)) * HTB)
#define PG8_STAGE(bufoff, gbase, voff) do { _Pragma("unroll") for (int _i = 0; _i < 2; ++_i) \
        __builtin_amdgcn_global_load_lds((const unsigned*)((const char*)(gbase) + (voff)[_i]), (PG8_LAS unsigned*)(lds + (bufoff) + ldsw + _i * 8192), 16, 0, 0); } while (0)
#define PG8_LDA(dst, b, h) do { _Pragma("unroll") for (int m = 0; m < 4; ++m) _Pragma("unroll") for (int k = 0; k < 2; ++k) dst[m][k] = *(const PG8_LAS bf16x8*)(lds + PG8_SA(b, h) + aoff + m * 2048 + k * 1024); } while (0)
#define PG8_LDB(dst, b, h) do { _Pragma("unroll") for (int n = 0; n < 2; ++n) _Pragma("unroll") for (int k = 0; k < 2; ++k) dst[n][k] = *(const PG8_LAS bf16x8*)(lds + PG8_SB(b, h) + boff + n * 2048 + k * 1024); } while (0)
#define PG8_MMA(ai, bj, At, Bt) do { __builtin_amdgcn_s_setprio(1); _Pragma("unroll") for (int m = 0; m < 4; ++m) _Pragma("unroll") for (int n = 0; n < 2; ++n) _Pragma("unroll") for (int k = 0; k < 2; ++k) \
        acc[ai][bj][m][n] = __builtin_amdgcn_mfma_f32_16x16x32_bf16(Bt[n][k], At[m][k], acc[ai][bj][m][n], 0, 0, 0); __builtin_amdgcn_s_setprio(0); } while (0)
#define PG8_WAIT_V(n) asm volatile("s_waitcnt vmcnt(" #n ")" ::: "memory")
#define PG8_WAIT_L(n) asm volatile("s_waitcnt lgkmcnt(" #n ")" ::: "memory")
#define PG8_BAR __builtin_amdgcn_s_barrier()
#define PG8_SCHED __builtin_amdgcn_sched_barrier(0)
    Unit cur, nxt; int ui = 0;
    if (!S.next(0, cur)) return;
    f32x4 acc[2][2][4][2];
#pragma unroll
    for (int a = 0; a < 2; ++a)
#pragma unroll
        for (int b = 0; b < 2; ++b)
#pragma unroll
            for (int m = 0; m < 4; ++m)
#pragma unroll
                for (int n = 0; n < 2; ++n) acc[a][b][m][n] = (f32x4){0.f, 0.f, 0.f, 0.f};
    bf16x8 At[4][2], B0[2][2], B1[2][2];
    const char* cA = (const char*)g.A + (size_t)cur.pm * tstepA + (size_t)cur.seg * g.a_seg * 2; const char* cB = (const char*)g.Bt + (size_t)cur.pn * tstepB + (size_t)cur.seg * g.b_seg * 2;
    PG8_STAGE(PG8_SB(0, 0), cB, voffB); PG8_STAGE(PG8_SB(0, 1), cB + hstepB, voffB); PG8_STAGE(PG8_SA(0, 0), cA, voffA); PG8_STAGE(PG8_SA(0, 1), cA + hstepA, voffA);
    if (wr == 1) PG8_BAR;
    PG8_WAIT_V(2); PG8_BAR;
    PG8_STAGE(PG8_SB(1, 0), cB + kstep, voffB); PG8_STAGE(PG8_SA(1, 0), cA + kstep, voffA); PG8_STAGE(PG8_SB(1, 1), cB + hstepB + kstep, voffB);
    PG8_WAIT_V(6); PG8_BAR;
    for (;;) {
        const bool has_next = S.next(ui + 1, nxt);
        const char* nA = has_next ? (const char*)g.A + (size_t)nxt.pm * tstepA + (size_t)nxt.seg * g.a_seg * 2 : cA;
        const char* nB = has_next ? (const char*)g.Bt + (size_t)nxt.pn * tstepB + (size_t)nxt.seg * g.b_seg * 2 : cB;
        for (int t = 0; t < nt; t += 2) {
            const bool last = (t == nt - 2);
            const char* a1 = cA + (size_t)(t + 1) * kstep;
            const char* a2 = last ? nA : cA + (size_t)(t + 2) * kstep; const char* b2 = last ? nB : cB + (size_t)(t + 2) * kstep;
            const char* a3 = a2 + kstep; const char* b3 = b2 + kstep;
            PG8_LDB(B0, 0, 0); PG8_LDB(B1, 0, 1); PG8_SCHED; PG8_LDA(At, 0, 0); PG8_STAGE(PG8_SA(1, 1), a1 + hstepA, voffA);
            PG8_WAIT_V(8); PG8_WAIT_L(0); PG8_BAR; PG8_MMA(0, 0, At, B0); PG8_MMA(0, 1, At, B1); PG8_BAR; PG8_SCHED;
            PG8_LDA(At, 0, 1); PG8_STAGE(PG8_SB(0, 0), b2, voffB); PG8_STAGE(PG8_SB(0, 1), b2 + hstepB, voffB); PG8_STAGE(PG8_SA(0, 0), a2, voffA);
            PG8_WAIT_V(8); PG8_WAIT_L(0); PG8_BAR; PG8_MMA(1, 0, At, B0); PG8_MMA(1, 1, At, B1); PG8_BAR; PG8_SCHED;
            PG8_LDB(B0, 1, 0); PG8_LDB(B1, 1, 1); PG8_SCHED; PG8_LDA(At, 1, 0); PG8_STAGE(PG8_SA(0, 1), a2 + hstepA, voffA);
            PG8_WAIT_V(8); PG8_WAIT_L(0); PG8_BAR; PG8_MMA(0, 0, At, B0); PG8_MMA(0, 1, At, B1); PG8_BAR; PG8_SCHED;
            PG8_LDA(At, 1, 1); PG8_STAGE(PG8_SB(1, 0), b3, voffB); PG8_STAGE(PG8_SB(1, 1), b3 + hstepB, voffB); PG8_STAGE(PG8_SA(1, 0), a3, voffA);
            PG8_WAIT_V(8); PG8_WAIT_L(0); PG8_BAR; PG8_MMA(1, 0, At, B0); PG8_MMA(1, 1, At, B1); PG8_BAR; PG8_SCHED;
        }
        if (wr == 0) PG8_BAR;
        const bool zero = E(acc, cur, wr, wc, fr, fq);
        if (!has_next) break;
        if (zero) {
#pragma unroll
        for (int a = 0; a < 2; ++a)
#pragma unroll
            for (int b = 0; b < 2; ++b)
#pragma unroll
                for (int m = 0; m < 4; ++m)
#pragma unroll
                    for (int n = 0; n < 2; ++n) acc[a][b][m][n] = (f32x4){0.f, 0.f, 0.f, 0.f};
        }
        cur = nxt; cA = nA; cB = nB; ++ui;
        if (wr == 1) PG8_BAR;
    }
    PG8_WAIT_V(0);
    PG8_BAR;
#undef PG8_SA
#undef PG8_SB
#undef PG8_STAGE
#undef PG8_LDA
#undef PG8_LDB
#undef PG8_MMA
#undef PG8_WAIT_V
#undef PG8_WAIT_L
#undef PG8_BAR
#undef PG8_SCHED
}
}
constexpr int NWAVES = 8;
constexpr int BATCH = 8, SEQ = 2048, DM = 2048, DEPTH = 2, HD = 128, NH = 8, MIXW = 1024, DFF = 5632;
constexpr int M = BATCH * SEQ;
constexpr int NQKV = 9216, NG = 6144, NCOLS = NQKV + NG;
constexpr float RMS_EPS = 1e-6f;
constexpr int C_QA = 0, C_KA = 1024, C_VA = 2048, C_QB = 3072, C_KB = 4096, C_VB = 5120, C_QC = 6144, C_KC = 7168, C_VC = 8192;

constexpr size_t MiB = 1u << 20;
constexpr size_t WS_CTL = 0, CTL_ZERO_BYTES = 1 * MiB;
constexpr size_t CTL_SS = 65536;
constexpr size_t WS_W = 2 * MiB;
constexpr size_t W_IN = 0, W_BR = 60 * MiB, W_OUT = 72 * MiB, W_GU = 80 * MiB, W_DN = 124 * MiB, W_LAYER = 146 * MiB;
constexpr size_t WS_QKV = WS_W + 2 * W_LAYER;
constexpr size_t WS_MERGED = WS_QKV, WS_HID = WS_QKV + 64 * MiB;
constexpr size_t WS_G = WS_QKV + 288 * MiB;
constexpr size_t WS_BRX = WS_G + 192 * MiB;
constexpr size_t WS_PARK = WS_BRX + 96 * MiB;
constexpr size_t WS_END = WS_PARK + 32 * MiB;
constexpr int CW_BAR = 4096;

constexpr int RING_OFF = 0, RING_BYTES = 131072;
constexpr int LDSCTL_OFF = RING_BYTES, MISC_OFF = LDSCTL_OFF + 320;
constexpr int LDS_BYTES = 147456;

#define GAS __attribute__((address_space(1)))
#define LAS __attribute__((address_space(3)))
typedef unsigned short bf16;
typedef unsigned v4u __attribute__((ext_vector_type(4)));
typedef unsigned v2u __attribute__((ext_vector_type(2)));
typedef float f32x4 __attribute__((ext_vector_type(4)));
typedef short bf16x8 __attribute__((ext_vector_type(8)));
typedef GAS unsigned gu32;
#define RLX_AGENT __ATOMIC_RELAXED, __HIP_MEMORY_SCOPE_AGENT
#define LDS_WAIT() asm volatile("s_waitcnt lgkmcnt(0)" ::: "memory")
#define VM_WAIT() asm volatile("s_waitcnt vmcnt(0)" ::: "memory")
__device__ __forceinline__ unsigned f2bf(float f) { unsigned u = __builtin_bit_cast(unsigned, f); return (u + 0x7fffu + ((u >> 16) & 1u)) >> 16; }
__device__ __forceinline__ unsigned pk2(float lo, float hi) { return f2bf(lo) | (f2bf(hi) << 16); }
__device__ __forceinline__ float bf2f(bf16 b) { return __uint_as_float((unsigned)b << 16); }

#define XB_TMO      128
#define XB_XCNT(j)  (256  + 64 * (j))
#define XB_XSUB(j)  (1280 + 64 * (j))
#define XB_XGEN(j)  (2304 + 64 * (j))
#define XB_TOP      3328
#define XB_TOPGEN   3392
#define XCD_BAR_WORDS 3456
#define XB_SPIN_CAP (1u << 18)
__device__ __forceinline__ unsigned xb_ld(unsigned* p)              { return __hip_atomic_load(p, __ATOMIC_RELAXED, __HIP_MEMORY_SCOPE_AGENT); }
__device__ __forceinline__ unsigned xb_add(unsigned* p, unsigned v) { return __hip_atomic_fetch_add(p, v, __ATOMIC_RELAXED, __HIP_MEMORY_SCOPE_AGENT); }
__device__ __forceinline__ unsigned xb_xcc_id() { return (unsigned)__builtin_amdgcn_s_getreg((3 << 11) | 20) & 0xFu; }
#define XB_SPIN(cond, bar) do { unsigned _sp = 0; while (cond) { __builtin_amdgcn_s_sleep(1); \
    if ((++_sp & 255u) == 0u) { if (xb_ld(&(bar)[XB_TMO])) break; if (_sp > XB_SPIN_CAP) { atomicAdd(&(bar)[XB_TMO], 1u); break; } } } } while (0)
struct XcdBarrier { unsigned* bar; unsigned x; volatile LAS unsigned* st; };
__device__ __forceinline__ XcdBarrier xcd_barrier_post(unsigned* bar, volatile LAS unsigned* st) {
    XcdBarrier b; b.bar = bar; b.x = xb_xcc_id(); b.st = st;
    if (threadIdx.x == 0) (void)xb_add(&bar[XB_XCNT(b.x)], 1u);
    return b;
}
__device__ __forceinline__ void xcd_barrier_complete(unsigned* bar, unsigned x, unsigned& nloc, unsigned& nx) {
    const unsigned G = gridDim.x * gridDim.y * gridDim.z;
    unsigned sum, cnt, mine, sp = 0u;
    for (;;) {
        sum = 0u; cnt = 0u; mine = 0u;
#pragma unroll
        for (unsigned j = 0; j < 16; ++j) { const unsigned c = xb_ld(&bar[XB_XCNT(j)]); sum += c; cnt += (c > 0u) ? 1u : 0u; mine = (j == x) ? c : mine; }
        if (sum == G) break;
        __builtin_amdgcn_s_sleep(1);
        if ((++sp & 255u) == 0u) { if (xb_ld(&bar[XB_TMO])) break; if (sp > XB_SPIN_CAP) { atomicAdd(&bar[XB_TMO], 1u); break; } }
    }
    nloc = mine > 0u ? mine : 1u; nx = cnt > 0u ? cnt : 1u;
}
__device__ __forceinline__ void xcd_barrier(const XcdBarrier& b) {
    asm volatile("s_waitcnt vmcnt(0)" ::: "memory");
    __syncthreads();
    if (threadIdx.x == 0) {
        unsigned* bar = b.bar;
        __builtin_amdgcn_s_waitcnt(0);
        unsigned nloc = b.st[0], nx = b.st[1];
        if (nloc == 0u) { xcd_barrier_complete(bar, b.x, nloc, nx); b.st[0] = nloc; b.st[1] = nx; }
        const unsigned old = xb_add(&bar[XB_XSUB(b.x)], 1u);
        const unsigned gen = old / nloc;
        if (old + 1u == (gen + 1u) * nloc) {
            __builtin_amdgcn_fence(__ATOMIC_RELEASE, "agent");
            asm volatile("s_waitcnt vmcnt(0)" ::: "memory");
            const unsigned og = xb_add(&bar[XB_TOP], 1u);
            const unsigned tg = og / nx;
            if (og + 1u == (tg + 1u) * nx) xb_add(&bar[XB_TOPGEN], 1u);
            else XB_SPIN(xb_ld(&bar[XB_TOPGEN]) == tg, bar);
            __builtin_amdgcn_fence(__ATOMIC_ACQUIRE, "agent");
            xb_add(&bar[XB_XGEN(b.x)], 1u);
            asm volatile("s_waitcnt vmcnt(0)" ::: "memory");
        } else {
            XB_SPIN(xb_ld(&bar[XB_XGEN(b.x)]) == gen, bar);
            __builtin_amdgcn_fence(__ATOMIC_ACQUIRE, "agent");
            asm volatile("s_waitcnt vmcnt(0)" ::: "memory");
        }
    }
    __syncthreads();
}

namespace pg8 {
struct EpiProj {
    static constexpr bool PERM = true;
    bf16_t* QKV; bf16_t* G; const float* ss;
    __device__ __forceinline__ bool operator()(f32x4 (&acc)[2][2][4][2], const Unit& u, int wr, int wc, int fr, int fq) const {
        int colt = u.pn * BM; bf16_t* base = QKV; int ldc = NQKV;
        if (u.pn >= NQKV / BM) { base = G; ldc = NG; colt -= NQKV; }
        const int row0 = u.pm * BM + wr * 64 + fr, col0 = colt + wc * 32 + 8 * fq;
#pragma unroll
        for (int ai = 0; ai < 2; ++ai)
#pragma unroll
            for (int m = 0; m < 4; ++m) { const int row = row0 + ai * HALF + m * 16; const float rs = rsqrtf(ss[row] * (1.0f / DM) + RMS_EPS);
                bf16_t* rowp = base + (size_t)row * ldc + col0;
#pragma unroll
                for (int bj = 0; bj < 2; ++bj) { const f32x4 v0 = acc[ai][bj][m][0] * rs, v1 = acc[ai][bj][m][1] * rs;
                    u32x4 w; w.x = cvt_pk_bf16(v0[0], v0[1]); w.y = cvt_pk_bf16(v0[2], v0[3]); w.z = cvt_pk_bf16(v1[0], v1[1]); w.w = cvt_pk_bf16(v1[2], v1[3]);
                    *(u32x4*)(rowp + bj * HALF) = w; } }
        return true;
    }
};
struct EpiMerge {
    static constexpr bool PERM = true;
    const bf16_t* G; const float* bg; bf16_t* O;
    __device__ __forceinline__ bool operator()(f32x4 (&acc)[2][2][4][2], const Unit& u, int wr, int wc, int fr, int fq) const {
        const int s = u.seg; const int row0 = u.pm * BM + wr * 64 + fr, col0 = u.pn * BM + wc * 32 + 8 * fq;
#pragma unroll
        for (int bj = 0; bj < 2; ++bj) {
            const int col = col0 + bj * HALF;
            const f32x4 ba0 = *(const f32x4*)(bg + s * DM + col), ba1 = *(const f32x4*)(bg + s * DM + col + 4);
            f32x4 bb0 = (f32x4){0.f, 0.f, 0.f, 0.f}, bb1 = bb0;
            if (s < 2) { bb0 = *(const f32x4*)(bg + (s + 1) * DM + col); bb1 = *(const f32x4*)(bg + (s + 1) * DM + col + 4); }
#pragma unroll
            for (int ai = 0; ai < 2; ++ai)
#pragma unroll
                for (int m = 0; m < 4; ++m) { const int row = row0 + ai * HALF + m * 16;
                    const u32x4 ga = *(const u32x4*)(G + (size_t)row * NG + s * DM + col);
                    float a[8] = {bf_lo(ga.x) + ba0[0], bf_hi(ga.x) + ba0[1], bf_lo(ga.y) + ba0[2], bf_hi(ga.y) + ba0[3], bf_lo(ga.z) + ba1[0], bf_hi(ga.z) + ba1[1], bf_lo(ga.w) + ba1[2], bf_hi(ga.w) + ba1[3]};
                    float f[8];
                    if (s < 2) {
                        const u32x4 gb = *(const u32x4*)(G + (size_t)row * NG + (s + 1) * DM + col);
                        float b[8] = {bf_lo(gb.x) + bb0[0], bf_hi(gb.x) + bb0[1], bf_lo(gb.y) + bb0[2], bf_hi(gb.y) + bb0[3], bf_lo(gb.z) + bb1[0], bf_hi(gb.z) + bb1[1], bf_lo(gb.w) + bb1[2], bf_hi(gb.w) + bb1[3]};
#pragma unroll
                        for (int e = 0; e < 8; ++e) f[e] = (1.0f + __expf(-b[e])) / (1.0f + __expf(-a[e]));
                    } else {
#pragma unroll
                        for (int e = 0; e < 8; ++e) f[e] = 1.0f / (1.0f + __expf(-a[e]));
                    }
                    f32x4 v0 = acc[ai][bj][m][0], v1 = acc[ai][bj][m][1];
                    v0[0] *= f[0]; v0[1] *= f[1]; v0[2] *= f[2]; v0[3] *= f[3]; v1[0] *= f[4]; v1[1] *= f[5]; v1[2] *= f[6]; v1[3] *= f[7];
                    acc[ai][bj][m][0] = v0; acc[ai][bj][m][1] = v1;
                    if (s == 2) { u32x4 w; w.x = cvt_pk_bf16(v0[0], v0[1]); w.y = cvt_pk_bf16(v0[2], v0[3]); w.z = cvt_pk_bf16(v1[0], v1[1]); w.w = cvt_pk_bf16(v1[2], v1[3]);
                        *(u32x4*)(O + (size_t)row * DM + col) = w; } }
        }
        return s == 2;
    }
};
struct EpiResid {
    static constexpr bool PERM = false;
    const float* xin; float* xout; bf16_t* xb; float* ss;
    __device__ __forceinline__ bool operator()(f32x4 (&acc)[2][2][4][2], const Unit& u, int wr, int wc, int fr, int fq) const {
        const int col0 = u.pn * BM + wc * 32 + 4 * fq;
#pragma unroll
        for (int ai = 0; ai < 2; ++ai)
#pragma unroll
            for (int m = 0; m < 4; ++m) { const int row = u.pm * BM + ai * HALF + wr * 64 + m * 16 + fr; const size_t off = (size_t)row * DM + col0; float q = 0.f;
#pragma unroll
                for (int bj = 0; bj < 2; ++bj)
#pragma unroll
                    for (int n = 0; n < 2; ++n) { const f32x4 xv = *(const f32x4*)(xin + off + bj * HALF + n * 16); const f32x4 o = xv + acc[ai][bj][m][n];
                        *(f32x4*)(xout + off + bj * HALF + n * 16) = o; q += (o[0] * o[0] + o[1] * o[1]) + (o[2] * o[2] + o[3] * o[3]);
                        u32x2 w; w.x = cvt_pk_bf16(o[0], o[1]); w.y = cvt_pk_bf16(o[2], o[3]); *(u32x2*)(xb + off + bj * HALF + n * 16) = w; }
                q += __shfl_xor(q, 16); q += __shfl_xor(q, 32);
                if (fq == 0) atomicAdd(ss + row, q); }
        return true;
    }
};
struct EpiSwiGLU {
    static constexpr bool PERM = true;
    bf16_t* H; const float* ss;
    __device__ __forceinline__ bool operator()(f32x4 (&acc)[2][2][4][2], const Unit& u, int wr, int wc, int fr, int fq) const {
        const int row0 = u.pm * BM + wr * 64 + fr, col0 = u.pn * HALF + wc * 32 + 8 * fq;
#pragma unroll
        for (int ai = 0; ai < 2; ++ai)
#pragma unroll
            for (int m = 0; m < 4; ++m) { const int row = row0 + ai * HALF + m * 16; const float rs = rsqrtf(ss[row] * (1.0f / DM) + RMS_EPS);
                float h[8];
#pragma unroll
                for (int n = 0; n < 2; ++n)
#pragma unroll
                    for (int e = 0; e < 4; ++e) { const float gv = acc[ai][0][m][n][e] * rs, uv = acc[ai][1][m][n][e] * rs; h[n * 4 + e] = gv / (1.0f + __expf(-gv)) * uv; }
                u32x4 w; w.x = cvt_pk_bf16(h[0], h[1]); w.y = cvt_pk_bf16(h[2], h[3]); w.z = cvt_pk_bf16(h[4], h[5]); w.w = cvt_pk_bf16(h[6], h[7]);
                *(u32x4*)(H + (size_t)row * DFF + col0) = w; }
        return true;
    }
};
}

struct Frame {
    LAS unsigned char* lds;
    volatile LAS unsigned* MISC;
    gu32* ctl;
    int tid, lane, wave;
    int vcu, G;
};
__device__ __forceinline__ float wave_sum(float v) {
#pragma unroll
    for (int o = 1; o < 64; o <<= 1) v += __shfl_xor(v, o);
    return v;
}
template <int MODE>
__device__ __forceinline__ void p0_transpose_item(const float* W, int K, int N, bf16* WT, int row_off, const float* gain, LAS float* scr, int item, int lane) {
    const int nblk = N / 32, kb = item / nblk, nb = item % nblk, k0 = 64 * kb, n0 = 32 * nb;
#pragma unroll 8
    for (int i = 0; i < 32; ++i) { const int kk = 2 * i + (lane >> 5); float v = W[(size_t)(k0 + kk) * N + n0 + (lane & 31)]; if (gain) v *= gain[k0 + kk]; scr[kk * 33 + (lane & 31)] = v; }
    LDS_WAIT(); asm volatile("" ::: "memory");
    const int c = lane & 7;
#pragma unroll
    for (int j = 0; j < 4; ++j) { const int n = (lane >> 3) + 8 * j; const LAS float* s = scr + (8 * c) * 33 + n;
        v4u o; o.x = pk2(s[0 * 33], s[1 * 33]); o.y = pk2(s[2 * 33], s[3 * 33]); o.z = pk2(s[4 * 33], s[5 * 33]); o.w = pk2(s[6 * 33], s[7 * 33]);
        const int nn = n0 + n; const int dr = (MODE == 0) ? (row_off + nn) : ((nn >> 7) * 256 + (nn & 127) + (MODE == 2 ? 128 : 0));
        *(GAS v4u*)(WT + (size_t)dr * K + k0 + 8 * c) = o; }
    LDS_WAIT(); asm volatile("" ::: "memory");
}
template <int MODE>
__global__ void __launch_bounds__(128) naive_attn(const bf16* __restrict__ QKV, bf16* __restrict__ BR, const float* lq1, const float* lk1, const float* lq2, const float* lk2,
                                                  const float* subln, float lambda_init) {
    __shared__ float sbuf[2][2][SEQ];
    __shared__ float qs[2][HD];
    const int w = threadIdx.x >> 6, lane = threadIdx.x & 63;
    const int rid = blockIdx.x * 2 + w; const int t = rid % SEQ, h = (rid / SEQ) % NH, b = rid / (SEQ * NH);
    const int qcol = (MODE == 0 ? C_QA : MODE == 1 ? C_QB : C_QC) + h * HD, kcol = (MODE == 0 ? C_KA : MODE == 1 ? C_KB : C_KC) + h * HD, vcol = (MODE == 0 ? C_VA : MODE == 1 ? C_VB : C_VC) + h * HD;
    const bf16* base = QKV + (size_t)b * SEQ * NQKV;
    { const unsigned qq = *(const unsigned*)(base + (size_t)t * NQKV + qcol + 2 * lane); qs[w][2 * lane] = __uint_as_float(qq << 16); qs[w][2 * lane + 1] = __uint_as_float(qq & 0xffff0000u); }
    __syncthreads();
    float* s0 = sbuf[w][0]; float* s1 = sbuf[w][1];
    for (int j = lane; j <= t; j += 64) {
        const v4u* kr = (const v4u*)(base + (size_t)j * NQKV + kcol); float a0 = 0.f, a1 = 0.f;
#pragma unroll 4
        for (int c = 0; c < 16; ++c) { const v4u kv = kr[c]; const float* q = &qs[w][c * 8]; float d = 0.f;
            d += __uint_as_float(kv.x << 16) * q[0] + __uint_as_float(kv.x & 0xffff0000u) * q[1];
            d += __uint_as_float(kv.y << 16) * q[2] + __uint_as_float(kv.y & 0xffff0000u) * q[3];
            d += __uint_as_float(kv.z << 16) * q[4] + __uint_as_float(kv.z & 0xffff0000u) * q[5];
            d += __uint_as_float(kv.w << 16) * q[6] + __uint_as_float(kv.w & 0xffff0000u) * q[7];
            if (c < 8) a0 += d; else a1 += d; }
        if (MODE == 0) { s0[j] = a0; s1[j] = a1; } else { s0[j] = a0 + a1; }
    }
    __syncthreads();
    if (MODE == 0) {
        const float lam = __expf(wave_sum(lq1[lane] * lk1[lane])) - __expf(wave_sum(lq2[lane] * lk2[lane])) + lambda_init;
        const float slope = exp2f(-(float)(2 * h + 1) * 0.5f);
        float mx0 = -INFINITY, mx1 = -INFINITY;
        for (int j = lane; j <= t; j += 64) { const float bias = slope * (float)(t - j); const float c0 = s0[j] * 0.125f - bias, c1 = s1[j] * 0.125f - bias; s0[j] = c0; s1[j] = c1; mx0 = fmaxf(mx0, c0); mx1 = fmaxf(mx1, c1); }
#pragma unroll
        for (int o = 1; o < 64; o <<= 1) { mx0 = fmaxf(mx0, __shfl_xor(mx0, o)); mx1 = fmaxf(mx1, __shfl_xor(mx1, o)); }
        float l0 = 0.f, l1 = 0.f;
        for (int j = lane; j <= t; j += 64) { const float p0 = __expf(s0[j] - mx0), p1 = __expf(s1[j] - mx1); s0[j] = p0; s1[j] = p1; l0 += p0; l1 += p1; }
        l0 = wave_sum(l0); l1 = wave_sum(l1);
        const float r0 = 1.0f / l0, r1 = lam / l1;
        for (int j = lane; j <= t; j += 64) s0[j] = s0[j] * r0 - s1[j] * r1;
    } else if (MODE == 1) {
        const float scale = 0.08838834764831845f; float carry = 0.f;
        for (int c = (t > 0 ? (t - 1) >> 6 : -1); c >= 0; --c) {
            const int j = c * 64 + lane; const bool ok = j < t;
            const float z = ok ? s0[j] * scale : 0.f;
            const float sp = fmaxf(z, 0.f) + log1pf(__expf(-fabsf(z)));
            const float lf = ok ? -sp : 0.f;
            float sc = lf;
#pragma unroll
            for (int o = 1; o < 64; o <<= 1) { const float v = __shfl_down(sc, o); if (lane + o < 64) sc += v; }
            const float suffix = carry + sc - lf;
            if (ok) s0[j] = __expf((z - sp) + suffix);
            carry += __shfl(sc, 0);
        }
        if (lane == 0) s0[t] = 0.f;
    } else {
        const float scale = 0.08838834764831845f; const float slope = exp2f(-(float)(h + 1)); const int own = t >> 8;
        float gate[8]; unsigned sel = 0u;
#pragma unroll
        for (int n = 0; n < 8; ++n) { float g = 0.f; if (n < own) { g = s0[n * 256 + lane] + s0[n * 256 + 64 + lane] + s0[n * 256 + 128 + lane] + s0[n * 256 + 192 + lane]; g = wave_sum(g); } gate[n] = g; }
        const int npick = own < 3 ? own : 3;
        for (int r = 0; r < npick; ++r) { int best = -1; float bv = -INFINITY;
#pragma unroll
            for (int n = 0; n < 8; ++n) if (n < own && !((sel >> n) & 1u) && (best < 0 || gate[n] > bv)) { best = n; bv = gate[n]; }
            sel |= 1u << best; }
        float mx = -INFINITY;
        for (int j = lane; j <= t; j += 64) { const int blk = j >> 8; const bool ok = (blk == own) || ((sel >> blk) & 1u);
            const float c0 = ok ? s0[j] * scale - slope * (float)(t - j) : -INFINITY; s0[j] = c0; mx = fmaxf(mx, c0); }
#pragma unroll
        for (int o = 1; o < 64; o <<= 1) mx = fmaxf(mx, __shfl_xor(mx, o));
        float l = 0.f;
        for (int j = lane; j <= t; j += 64) { const float p = __expf(s0[j] - mx); s0[j] = p; l += p; }
        l = wave_sum(l); const float r = 1.0f / l;
        for (int j = lane; j <= t; j += 64) s0[j] *= r;
    }
    __syncthreads();
    float o0 = 0.f, o1 = 0.f;
    for (int j = 0; j <= t; ++j) { const float wgt = s0[j]; const unsigned vv = *(const unsigned*)(base + (size_t)j * NQKV + vcol + 2 * lane);
        o0 += wgt * __uint_as_float(vv << 16); o1 += wgt * __uint_as_float(vv & 0xffff0000u); }
    if (MODE == 0) {
        const float ms = wave_sum(o0 * o0 + o1 * o1) * (1.0f / HD); const float r = rsqrtf(ms + RMS_EPS) * (1.0f - lambda_init);
        o0 = o0 * r * subln[2 * lane]; o1 = o1 * r * subln[2 * lane + 1];
    }
    *(unsigned*)(BR + (size_t)(b * SEQ + t) * (3 * MIXW) + MODE * MIXW + h * HD + 2 * lane) = pk2(o0, o1);
}
namespace att {
typedef float f32x16 __attribute__((ext_vector_type(16)));
typedef short v4i16_t __attribute__((ext_vector_type(4)));
constexpr int KBUF = 0, VBUF = 32768, TILE_B = 16384, SCR = 65536;
constexpr float LOG2E = 1.4426950408889634f;
__device__ __forceinline__ int crow(int r, int hi) { return (r & 3) + 8 * (r >> 2) + 4 * hi; }
__device__ __forceinline__ int swz(int row, int ch) { return row * 256 + 16 * (ch ^ (((row & 3) << 2) | ((row >> 2) & 3))); }
__device__ __forceinline__ float xsum32(float v) { auto rr = __builtin_amdgcn_permlane32_swap(__float_as_uint(v), __float_as_uint(v), false, false); return __uint_as_float(rr[0]) + __uint_as_float(rr[1]); }
__device__ __forceinline__ float xmax32(float v) { auto rr = __builtin_amdgcn_permlane32_swap(__float_as_uint(v), __float_as_uint(v), false, false); return fmaxf(__uint_as_float(rr[0]), __uint_as_float(rr[1])); }
__device__ __forceinline__ float xget32(float v, int hi) { auto rr = __builtin_amdgcn_permlane32_swap(__float_as_uint(v), __float_as_uint(v), false, false); return __uint_as_float(hi ? rr[0] : rr[1]); }
__device__ __forceinline__ bf16x8 pack8(const f32x16& p, int b) {
    v4u w; w.x = pg8::cvt_pk_bf16(p[b + 0], p[b + 1]); w.y = pg8::cvt_pk_bf16(p[b + 2], p[b + 3]); w.z = pg8::cvt_pk_bf16(p[b + 4], p[b + 5]); w.w = pg8::cvt_pk_bf16(p[b + 6], p[b + 7]);
    return __builtin_bit_cast(bf16x8, w);
}
__device__ __forceinline__ bf16x8 vfrag(const LAS unsigned char* p0, const LAS unsigned char* p1) {
    const v4i16_t lo = __builtin_amdgcn_ds_read_tr16_b64_v4i16((LAS v4i16_t*)p0), hi = __builtin_amdgcn_ds_read_tr16_b64_v4i16((LAS v4i16_t*)p1);
    return (bf16x8){lo[0], lo[1], lo[2], lo[3], hi[0], hi[1], hi[2], hi[3]};
}
#define ATT_MFMA(a, b, c) __builtin_amdgcn_mfma_f32_32x32x16_bf16((a), (b), (c), 0, 0, 0)

template <int MODE, int MM>
__device__ __forceinline__ void attn_unit(LAS unsigned char* lds, const bf16* __restrict__ QKV, bf16* __restrict__ BR, int b, int h, int qb, float lam, float out_scale, const float* __restrict__ subln, float* park) {
    int tid_ = threadIdx.x; asm volatile("" : "+v"(tid_));
    const int tid = tid_, lane = tid & 63, r32 = lane & 31, hi = lane >> 5, wid = __builtin_amdgcn_readfirstlane(tid >> 6);
    constexpr int qcol0 = (MODE == 0 ? C_QA : MODE == 1 ? C_QB : C_QC), kcol0 = (MODE == 0 ? C_KA : MODE == 1 ? C_KB : C_KC), vcol0 = (MODE == 0 ? C_VA : MODE == 1 ? C_VB : C_VC);
    const bf16* base = QKV + (size_t)b * SEQ * NQKV;
    const int q0 = qb * 256, tq = q0 + wid * 32 + r32;
    const int wrow0 = q0 + wid * 32;
    const int NT = 4 * (qb + 1);
    const int srow = tid >> 4, sch = tid & 15;
    const bf16* kg = base + (size_t)srow * NQKV + kcol0 + h * HD + sch * 8;
    const bf16* vg = base + (size_t)srow * NQKV + vcol0 + h * HD + sch * 8;
    const int sw = swz(srow, sch);
    v4u sk0, sk1, sv0, sv1;
#define ATT_LOAD(T) do { const size_t o_ = (size_t)(T) * 64 * NQKV; sk0 = *(const v4u*)(kg + o_); sk1 = *(const v4u*)(kg + o_ + (size_t)32 * NQKV); sv0 = *(const v4u*)(vg + o_); sv1 = *(const v4u*)(vg + o_ + (size_t)32 * NQKV); } while (0)
#define ATT_WRITE(buf) do { LAS unsigned char* kb_ = lds + KBUF + (buf) * TILE_B + sw; LAS unsigned char* vb_ = lds + VBUF + (buf) * TILE_B + sw; \
        *(LAS v4u*)kb_ = sk0; *(LAS v4u*)(kb_ + 8192) = sk1; *(LAS v4u*)vb_ = sv0; *(LAS v4u*)(vb_ + 8192) = sv1; } while (0)
#define ATT_TILE(i) (MODE == 0 ? (i) : MODE == 1 ? (NT - 1 - (i)) : ((i) < 4 ? 4 * qb + (i) : (i) - 4))
    ATT_LOAD(ATT_TILE(0));
    constexpr int NS = (MODE == 0 ? 4 : 8), S0 = (MODE == 0 ? 4 * MM : 0);
    bf16x8 qr[NS];
    { const bf16* qg = base + (size_t)tq * NQKV + qcol0 + h * HD + hi * 8 + S0 * 16;
#pragma unroll
      for (int s = 0; s < NS; ++s) qr[s] = *(const bf16x8*)(qg + s * 16); }
    const int xk = ((r32 & 3) << 2) | ((r32 >> 2) & 3);
    const int kbase = r32 * 256;
    const int q4 = (lane & 15) >> 2, p4 = lane & 3, blk = (lane >> 4) & 1;
    int vbase[2];
#pragma unroll
    for (int t = 0; t < 2; ++t) vbase[t] = (4 * hi + q4) * 256 + 16 * ((2 * blk + (p4 >> 1)) ^ ((2 * t + hi) & 3)) + 8 * (p4 & 1) + t * 2048;

    unsigned sel = 0u;
    if (MODE == 2) {
        sel = (1u << qb) - 1u;
        if (qb >= 4) {
            LAS float* part = (LAS float*)(lds + SCR);
            LAS float* km = (LAS float*)(lds + SCR + 16384);
            for (int n = 0; n < qb; ++n) {
                float a[8] = {0.f, 0.f, 0.f, 0.f, 0.f, 0.f, 0.f, 0.f};
#pragma unroll
                for (int i = 0; i < 8; ++i) { const v4u kv = *(const v4u*)(kg + (size_t)(n * 256 + i * 32) * NQKV);
                    a[0] += pg8::bf_lo(kv.x); a[1] += pg8::bf_hi(kv.x); a[2] += pg8::bf_lo(kv.y); a[3] += pg8::bf_hi(kv.y); a[4] += pg8::bf_lo(kv.z); a[5] += pg8::bf_hi(kv.z); a[6] += pg8::bf_lo(kv.w); a[7] += pg8::bf_hi(kv.w); }
                *(LAS f32x4*)(part + srow * 128 + sch * 8) = (f32x4){a[0], a[1], a[2], a[3]}; *(LAS f32x4*)(part + srow * 128 + sch * 8 + 4) = (f32x4){a[4], a[5], a[6], a[7]};
                __syncthreads();
                if (tid < 128) { float s = 0.f;
#pragma unroll
                    for (int i = 0; i < 32; ++i) s += part[i * 128 + tid];
                    km[n * 128 + tid] = s; }
                __syncthreads();
            }
            float gate[8];
#pragma unroll
            for (int n = 0; n < 8; ++n) { float g = 0.f;
                if (n < qb) {
#pragma unroll
                    for (int s = 0; s < 8; ++s) { const f32x4 k0 = *(const LAS f32x4*)(km + n * 128 + s * 16 + hi * 8), k1 = *(const LAS f32x4*)(km + n * 128 + s * 16 + hi * 8 + 4);
                        const v4u qq = __builtin_bit_cast(v4u, qr[s]);
                        g += pg8::bf_lo(qq.x) * k0[0] + pg8::bf_hi(qq.x) * k0[1] + pg8::bf_lo(qq.y) * k0[2] + pg8::bf_hi(qq.y) * k0[3] + pg8::bf_lo(qq.z) * k1[0] + pg8::bf_hi(qq.z) * k1[1] + pg8::bf_lo(qq.w) * k1[2] + pg8::bf_hi(qq.w) * k1[3]; }
                    g = xsum32(g); }
                gate[n] = g; }
            sel = 0u;
#pragma unroll
            for (int r = 0; r < 3; ++r) { int best = 0; float bv = -INFINITY; bool have = false;
#pragma unroll
                for (int n = 0; n < 8; ++n) { const bool cand = (n < qb) && !((sel >> n) & 1u) && (!have || gate[n] > bv); if (cand) { best = n; bv = gate[n]; have = true; } }
                sel |= 1u << best; }
            __syncthreads();
        }
    }

    f32x16 o1[4];
#pragma unroll
    for (int c = 0; c < 4; ++c) o1[c] = (f32x16){};
    float m1 = -INFINITY, l1 = 0.f, carry = 0.f;
    const float slope2 = (MODE == 0 ? exp2f(-(float)(2 * h + 1) * 0.5f) : exp2f(-(float)(h + 1))) * LOG2E;
    const float c1 = (MODE == 0 ? 0.125f : 0.08838834764831845f) * LOG2E;

    asm volatile("s_waitcnt vmcnt(0)" ::: "memory");
    ATT_WRITE(0);
    __syncthreads();

    for (int i = 0; i < NT; ++i) {
        const int T = ATT_TILE(i), buf = i & 1;
        if (i + 1 < NT) ATT_LOAD(ATT_TILE(i + 1));
        const LAS unsigned char* kb = lds + KBUF + buf * TILE_B + kbase;
        const LAS unsigned char* vb = lds + VBUF + buf * TILE_B;
        const int key0 = T * 64;
        int xkv = xk, q4v = q4; asm volatile("" : "+v"(xkv), "+v"(q4v));
        const bool active = key0 <= wrow0 + 31;
        const bool band = key0 + 63 >= wrow0;
        bool allowed = true;
        if (MODE == 2 && i >= 4) allowed = (sel >> (T >> 2)) & 1u;
        if (active && (MODE != 2 || __any(allowed))) {
            bf16x8 pa[2][2];
            if (MODE == 0 || MODE == 2) {
                f32x16 s0 = (f32x16){}, s1 = (f32x16){};
#pragma unroll
                for (int s = 0; s < NS; ++s) { const int ko = 16 * ((2 * (S0 + s) + hi) ^ xkv);
                    const bf16x8 k0 = *(const LAS bf16x8*)(kb + ko), k1 = *(const LAS bf16x8*)(kb + 8192 + ko);
                    s0 = ATT_MFMA(k0, qr[s], s0); s1 = ATT_MFMA(k1, qr[s], s1); }
                const float kb0 = slope2 * (float)(key0 + 4 * hi - tq), kb1 = slope2 * (float)(key0 + 32 + 4 * hi - tq);
                float mx = -INFINITY;
#pragma unroll
                for (int r = 0; r < 16; ++r) { const float cr = (float)((r & 3) + 8 * (r >> 2)); float a = fmaf(s0[r], c1, fmaf(slope2, cr, kb0)), c = fmaf(s1[r], c1, fmaf(slope2, cr, kb1));
                    if (band) { if (key0 + crow(r, hi) > tq) a = -INFINITY; if (key0 + 32 + crow(r, hi) > tq) c = -INFINITY; }
                    if (MODE == 2) { if (!allowed) { a = -INFINITY; c = -INFINITY; } }
                    s0[r] = a; s1[r] = c; mx = fmaxf(mx, fmaxf(a, c)); }
                mx = xmax32(mx);
                const float mn = fmaxf(m1, mx); const float alpha = __builtin_amdgcn_exp2f(m1 - mn); m1 = mn;
                float ps = 0.f;
#pragma unroll
                for (int r = 0; r < 16; ++r) { const float a = __builtin_amdgcn_exp2f(s0[r] - mn), c = __builtin_amdgcn_exp2f(s1[r] - mn); s0[r] = a; s1[r] = c; ps += a + c; }
                l1 = l1 * alpha + ps;
                pa[0][0] = pack8(s0, 0); pa[0][1] = pack8(s0, 8); pa[1][0] = pack8(s1, 0); pa[1][1] = pack8(s1, 8);
#pragma unroll
                for (int c = 0; c < 4; ++c) o1[c] *= alpha;
            } else {
#pragma unroll
                for (int sbi = 0; sbi < 2; ++sbi) { const int sb = 1 - sbi;
                    f32x16 s0 = (f32x16){};
#pragma unroll
                    for (int s = 0; s < 8; ++s) { const int ko = 16 * ((2 * s + hi) ^ xkv); const bf16x8 k0 = *(const LAS bf16x8*)(kb + sb * 8192 + ko); s0 = ATT_MFMA(k0, qr[s], s0); }
                    float lf[16], yl[16];
#pragma unroll
                    for (int r = 0; r < 16; ++r) { const float y = s0[r] * c1; const float sp = fmaxf(y, 0.f) + __builtin_amdgcn_logf(1.0f + __builtin_amdgcn_exp2f(-fabsf(y)));
                        const bool ok = !band || (key0 + sb * 32 + crow(r, hi) < tq);
                        lf[r] = ok ? -sp : 0.f; yl[r] = ok ? (y - sp) : -INFINITY; }
                    float a[4], e[16];
#pragma unroll
                    for (int rg = 0; rg < 4; ++rg) { e[4 * rg + 3] = 0.f; e[4 * rg + 2] = lf[4 * rg + 3]; e[4 * rg + 1] = e[4 * rg + 2] + lf[4 * rg + 2]; e[4 * rg + 0] = e[4 * rg + 1] + lf[4 * rg + 1]; a[rg] = e[4 * rg + 0] + lf[4 * rg + 0]; }
                    float p[4];
#pragma unroll
                    for (int rg = 0; rg < 4; ++rg) p[rg] = xget32(a[rg], hi);
                    const float sa3 = 0.f, sa2 = a[3], sa1 = a[3] + a[2], sa0 = sa1 + a[1];
                    const float sp3 = p[3], sp2 = p[3] + p[2], sp1 = sp2 + p[1], sp0 = sp1 + p[0];
                    float gs[4];
                    gs[0] = sa0 + (hi ? sp1 : sp0); gs[1] = sa1 + (hi ? sp2 : sp1); gs[2] = sa2 + (hi ? sp3 : sp2); gs[3] = sa3 + (hi ? 0.f : sp3);
                    const float tot = xsum32(sa0 + a[0]);
#pragma unroll
                    for (int r = 0; r < 16; ++r) s0[r] = __builtin_amdgcn_exp2f(yl[r] + (carry + gs[r >> 2] + e[r]));
                    carry += tot;
                    pa[sb][0] = pack8(s0, 0); pa[sb][1] = pack8(s0, 8);
                }
            }
#pragma unroll
            for (int sb = 0; sb < 2; ++sb)
#pragma unroll
                for (int sp = 0; sp < 2; ++sp)
#pragma unroll
                    for (int c = 0; c < 4; ++c) { const int off = 64 * (c ^ q4v) + sb * 8192 + sp * 4096;
                        const bf16x8 vf = vfrag(vb + vbase[0] + off, vb + vbase[1] + off);
                        o1[c] = ATT_MFMA(vf, pa[sb][sp], o1[c]); }
        }
        if (i + 1 < NT) { asm volatile("s_waitcnt vmcnt(0)" ::: "memory"); ATT_WRITE(buf ^ 1); }
        __syncthreads();
    }
    bf16* orow = BR + (size_t)(b * SEQ + tq) * (3 * MIXW) + MODE * MIXW + h * HD;
    if (MODE == 0) {
        l1 = xsum32(l1);
        f32x4* pk = (f32x4*)park + (size_t)(blockIdx.x * NWAVES + wid) * 16 * 64 + lane;
        if (MM == 0) {
            const float r1 = 1.0f / l1;
#pragma unroll
            for (int c = 0; c < 4; ++c)
#pragma unroll
                for (int rg = 0; rg < 4; ++rg) pk[(c * 4 + rg) * 64] = (f32x4){o1[c][4 * rg] * r1, o1[c][4 * rg + 1] * r1, o1[c][4 * rg + 2] * r1, o1[c][4 * rg + 3] * r1};
        } else {
            const float r2 = lam / l1; float ss = 0.f;
#pragma unroll
            for (int c = 0; c < 4; ++c)
#pragma unroll
                for (int rg = 0; rg < 4; ++rg) { const f32x4 a1 = pk[(c * 4 + rg) * 64];
#pragma unroll
                    for (int e = 0; e < 4; ++e) { const float v = a1[e] - o1[c][4 * rg + e] * r2; o1[c][4 * rg + e] = v; ss += v * v; } }
            ss = xsum32(ss);
            const float rn = rsqrtf(ss * (1.0f / HD) + RMS_EPS) * out_scale;
#pragma unroll
            for (int c = 0; c < 4; ++c)
#pragma unroll
                for (int rg = 0; rg < 4; ++rg) { const int dv = 32 * c + 8 * rg + 4 * hi; const f32x4 w = *(const f32x4*)(subln + dv);
                    v2u o; o.x = pg8::cvt_pk_bf16(o1[c][4 * rg] * rn * w[0], o1[c][4 * rg + 1] * rn * w[1]); o.y = pg8::cvt_pk_bf16(o1[c][4 * rg + 2] * rn * w[2], o1[c][4 * rg + 3] * rn * w[3]);
                    *(v2u*)(orow + dv) = o; }
        }
    } else {
        float rn = 1.0f;
        if (MODE == 2) { l1 = xsum32(l1); rn = 1.0f / l1; }
#pragma unroll
        for (int c = 0; c < 4; ++c)
#pragma unroll
            for (int rg = 0; rg < 4; ++rg) { const int dv = 32 * c + 8 * rg + 4 * hi;
                v2u o; o.x = pg8::cvt_pk_bf16(o1[c][4 * rg] * rn, o1[c][4 * rg + 1] * rn); o.y = pg8::cvt_pk_bf16(o1[c][4 * rg + 2] * rn, o1[c][4 * rg + 3] * rn);
                *(v2u*)(orow + dv) = o; }
    }
#undef ATT_LOAD
#undef ATT_WRITE
#undef ATT_TILE
}

__device__ __forceinline__ void attn_phase(LAS unsigned char* lds, const bf16* QKV, bf16* BR, float* park, int vcu, int G, const float* lq1, const float* lk1, const float* lq2, const float* lk2, const float* subln, float lambda_init) {
    int lane_ = threadIdx.x & 63; asm volatile("" : "+v"(lane_)); const int lane = lane_;
    const float lam = __expf(wave_sum(lq1[lane] * lk1[lane])) - __expf(wave_sum(lq2[lane] * lk2[lane])) + lambda_init;
#ifndef ATT_MASK
#define ATT_MASK 7
#endif
    if (ATT_MASK & 1) for (int u = vcu; u < 256; u += G) {
        const int bh = u >> 2, s = u & 3, b = bh >> 3, h = bh & 7;
        attn_unit<0, 0>(lds, QKV, BR, b, h, 7 - s, lam, 1.0f - lambda_init, subln, park);
        attn_unit<0, 1>(lds, QKV, BR, b, h, 7 - s, lam, 1.0f - lambda_init, subln, park);
        attn_unit<0, 0>(lds, QKV, BR, b, h, s, lam, 1.0f - lambda_init, subln, park);
        attn_unit<0, 1>(lds, QKV, BR, b, h, s, lam, 1.0f - lambda_init, subln, park);
    }
    if (ATT_MASK & 2) for (int u = vcu; u < 256; u += G) {
        const int bh = u >> 2, s = u & 3, b = bh >> 3, h = bh & 7;
        attn_unit<1, 0>(lds, QKV, BR, b, h, 7 - s, lam, 1.0f, subln, park);
        attn_unit<1, 0>(lds, QKV, BR, b, h, s, lam, 1.0f, subln, park);
    }
    if (ATT_MASK & 4) for (int u = vcu; u < 256; u += G) {
        const int bh = u >> 2, s = u & 3, b = bh >> 3, h = bh & 7;
        attn_unit<2, 0>(lds, QKV, BR, b, h, 7 - s, lam, 1.0f, subln, park);
        attn_unit<2, 0>(lds, QKV, BR, b, h, s, lam, 1.0f, subln, park);
    }
}
}
struct Args { const float* in[16]; float* out; unsigned char* ws; int ph_lo, ph_hi; };
constexpr int N_PHASES = 14;

__device__ __forceinline__ void p0_prologue(Frame& F0, const Args& a) {
    struct { int lane, wave, vcu, G; LAS unsigned char* lds; } F; { int t_ = threadIdx.x; asm volatile("" : "+v"(t_)); F.lane = t_ & 63; F.wave = __builtin_amdgcn_readfirstlane(t_ >> 6); F.vcu = F0.vcu; F.G = F0.G; F.lds = F0.lds; }
    LAS float* scr = (LAS float*)(F.lds + RING_OFF + F.wave * 16384);
    const int gw = F.vcu * NWAVES + F.wave, NGW = F.G * NWAVES;
    constexpr int I_IN = (DM / 64) * (NCOLS / 32), I_BR = (MIXW / 64) * (DM / 32), I_OUT = (DM / 64) * (DM / 32), I_GU = (DM / 64) * (DFF / 32), I_DN = (DFF / 64) * (DM / 32);
    constexpr int I_LAYER = I_IN + 3 * I_BR + I_OUT + 2 * I_GU + I_DN;
    for (int it = gw; it < DEPTH * I_LAYER; it += NGW) {
        const int l = it / I_LAYER; int r = it - l * I_LAYER;
        unsigned char* wl = a.ws + WS_W + (size_t)l * W_LAYER;
        if (r < I_IN) { p0_transpose_item<0>(a.in[3] + (size_t)l * DM * NCOLS, DM, NCOLS, (bf16*)(wl + W_IN), 0, a.in[1] + l * DM, scr, r, F.lane); continue; } r -= I_IN;
        if (r < 3 * I_BR) { const int i = r / I_BR; r -= i * I_BR;
            p0_transpose_item<0>(a.in[10] + ((size_t)l * 3 + i) * MIXW * DM, MIXW, DM, (bf16*)(wl + W_BR) + (size_t)i * DM * MIXW, 0, nullptr, scr, r, F.lane); continue; } r -= 3 * I_BR;
        if (r < I_OUT) { p0_transpose_item<0>(a.in[11] + (size_t)l * DM * DM, DM, DM, (bf16*)(wl + W_OUT), 0, nullptr, scr, r, F.lane); continue; } r -= I_OUT;
        if (r < I_GU) { p0_transpose_item<1>(a.in[12] + (size_t)l * DM * DFF, DM, DFF, (bf16*)(wl + W_GU), 0, a.in[2] + l * DM, scr, r, F.lane); continue; } r -= I_GU;
        if (r < I_GU) { p0_transpose_item<2>(a.in[13] + (size_t)l * DM * DFF, DM, DFF, (bf16*)(wl + W_GU), 0, a.in[2] + l * DM, scr, r, F.lane); continue; } r -= I_GU;
        p0_transpose_item<0>(a.in[14] + (size_t)l * DFF * DM, DFF, DM, (bf16*)(wl + W_DN), 0, nullptr, scr, r, F.lane);
    }
    bf16* xb = (bf16*)(a.ws + WS_BRX); float* ss0 = (float*)(a.ws + CTL_SS);
    for (int m = gw; m < M; m += NGW) {
        const GAS f32x4* xr = (const GAS f32x4*)(a.in[0] + (size_t)m * DM) + F.lane; GAS v2u* o8 = (GAS v2u*)(xb + (size_t)m * DM) + F.lane; float s = 0.f;
#pragma unroll
        for (int j = 0; j < 8; ++j) { const f32x4 v = xr[64 * j]; s += (v.x * v.x + v.y * v.y) + (v.z * v.z + v.w * v.w); v2u o; o.x = pk2(v.x, v.y); o.y = pk2(v.z, v.w); o8[64 * j] = o; }
        s = wave_sum(s); if (F.lane == 0) ss0[m] = s;
    }
}
__device__ __forceinline__ void p_final_norm(Frame& F0, const Args& a) {
    struct { int lane, wave, vcu, G; } F; { int t_ = threadIdx.x; asm volatile("" : "+v"(t_)); F.lane = t_ & 63; F.wave = __builtin_amdgcn_readfirstlane(t_ >> 6); F.vcu = F0.vcu; F.G = F0.G; }
    const int gw = F.vcu * NWAVES + F.wave, NGW = F.G * NWAVES; const float* ss = (const float*)(a.ws + CTL_SS) + 4 * M; const float* g = a.in[15];
    for (int m = gw; m < M; m += NGW) {
        GAS f32x4* xr = (GAS f32x4*)(a.out + (size_t)m * DM) + F.lane; const float rs = rsqrtf(ss[m] * (1.0f / DM) + RMS_EPS);
#pragma unroll
        for (int j = 0; j < 8; ++j) { const f32x4 v = xr[64 * j]; const f32x4 gv = *((const f32x4*)g + F.lane + 64 * j); xr[64 * j] = v * rs * gv; }
    }
}

__global__ void __launch_bounds__(NWAVES * 64, 2) fwd(Args args) {
    extern __shared__ __attribute__((aligned(16))) unsigned char lds[];
    Frame F;
    F.lds = (LAS unsigned char*)lds;
    F.MISC = (volatile LAS unsigned*)(F.lds + MISC_OFF);
    F.tid = threadIdx.x; F.lane = F.tid & 63; F.wave = __builtin_amdgcn_readfirstlane(F.tid >> 6);
    F.G = gridDim.x; { const int bx = blockIdx.x; F.vcu = (F.G % 8 == 0) ? (bx % 8) * (F.G / 8) + bx / 8 : bx; }
    unsigned char* ws = args.ws;
    F.ctl = (gu32*)(ws + WS_CTL);
    for (int u = F.tid; u < (LDS_BYTES - LDSCTL_OFF) / 4; u += NWAVES * 64) ((LAS unsigned*)(F.lds + LDSCTL_OFF))[u] = 0u;
    __syncthreads();
    const int lo = args.ph_lo, hi = args.ph_hi;
    XcdBarrier bar; bar.bar = (unsigned*)(F.ctl + CW_BAR); bar.x = 0; bar.st = nullptr;
    if (hi - lo > 1) bar = xcd_barrier_post((unsigned*)(F.ctl + CW_BAR), F.MISC + 8);
#ifndef PH_MASK
#define PH_MASK 0x3f
#endif
#define IN(k) (lo <= (k) && (k) < hi)
#define EN(j) ((PH_MASK >> (j)) & 1)
#define SEAM(k) do { if (IN(k) && IN((k) + 1)) xcd_barrier(bar); } while (0)
    float* ssb = (float*)(ws + CTL_SS);
    bf16* QKV = (bf16*)(ws + WS_QKV); bf16* GB = (bf16*)(ws + WS_G); bf16* BR = (bf16*)(ws + WS_BRX); bf16* XB = (bf16*)(ws + WS_BRX);
    bf16* MERGED = (bf16*)(ws + WS_MERGED); bf16* HID = (bf16*)(ws + WS_HID);

    if (IN(0)) { p0_prologue(F, args); SEAM(0); }
    for (int l = 0; l < DEPTH; ++l) {
        const int pb = 1 + 6 * l;
        unsigned char* wl = ws + WS_W + (size_t)l * W_LAYER;
        if (EN(0) && IN(pb + 0)) {
            pg8::Gemm g{XB, (const bf16*)(wl + W_IN), DM, DM, DM, 0, 0}; pg8::StaticOrder S; S.init(M, NCOLS, F.G, (int)blockIdx.x);
            pg8::EpiProj E{QKV, GB, ssb + (size_t)(2 * l) * M};
            pg8::gemm_phase<pg8::EpiProj, pg8::StaticOrder>(F.lds + RING_OFF, g, S, E);
            SEAM(pb + 0);
        }
        if (EN(1) && IN(pb + 1)) {
            att::attn_phase(F.lds + RING_OFF, QKV, BR, (float*)(ws + WS_PARK), F.vcu, F.G, args.in[5] + l * 64, args.in[6] + l * 64, args.in[7] + l * 64, args.in[8] + l * 64, args.in[9] + l * HD, 0.8f - 0.6f * __expf(-0.3f * (float)l));
            SEAM(pb + 1);
        }
        if (EN(2) && IN(pb + 2)) {
            pg8::Gemm g{BR, (const bf16*)(wl + W_BR), 3 * MIXW, MIXW, MIXW, MIXW, (long)DM * MIXW}; pg8::StaticOrder S; S.init(M, DM, F.G, (int)blockIdx.x, 3);
            pg8::EpiMerge E{GB, args.in[4] + (size_t)l * NG, MERGED};
            pg8::gemm_phase<pg8::EpiMerge, pg8::StaticOrder>(F.lds + RING_OFF, g, S, E);
            SEAM(pb + 2);
        }
        if (EN(3) && IN(pb + 3)) {
            pg8::Gemm g{MERGED, (const bf16*)(wl + W_OUT), DM, DM, DM, 0, 0}; pg8::StaticOrder S; S.init(M, DM, F.G, (int)blockIdx.x);
            pg8::EpiResid E{l == 0 ? args.in[0] : args.out, args.out, XB, ssb + (size_t)(2 * l + 1) * M};
            pg8::gemm_phase<pg8::EpiResid, pg8::StaticOrder>(F.lds + RING_OFF, g, S, E);
            SEAM(pb + 3);
        }
        if (EN(4) && IN(pb + 4)) {
            pg8::Gemm g{XB, (const bf16*)(wl + W_GU), DM, DM, DM, 0, 0}; pg8::StaticOrder S; S.init(M, 2 * DFF, F.G, (int)blockIdx.x);
            pg8::EpiSwiGLU E{HID, ssb + (size_t)(2 * l + 1) * M};
            pg8::gemm_phase<pg8::EpiSwiGLU, pg8::StaticOrder>(F.lds + RING_OFF, g, S, E);
            SEAM(pb + 4);
        }
        if (EN(5) && IN(pb + 5)) {
            pg8::Gemm g{HID, (const bf16*)(wl + W_DN), DFF, DFF, DFF, 0, 0}; pg8::StaticOrder S; S.init(M, DM, F.G, (int)blockIdx.x);
            pg8::EpiResid E{args.out, args.out, XB, ssb + (size_t)(2 * l + 2) * M};
            pg8::gemm_phase<pg8::EpiResid, pg8::StaticOrder>(F.lds + RING_OFF, g, S, E);
            SEAM(pb + 5);
        }
    }
    if (IN(13)) p_final_norm(F, args);
#undef IN
#undef SEAM
}

extern "C" void kernel_launch(void* const* d_in, const int* in_sizes, int n_in, void* d_out, int out_size, void* d_ws, size_t ws_size, hipStream_t stream) {
    static int grid = 0;
    if (grid == 0) {
        if (n_in != 16 || out_size != M * DM || ws_size < WS_END) { fprintf(stderr, "kernel_launch: unexpected shapes (n_in %d out %d ws %zu)\n", n_in, out_size, ws_size); grid = -1; return; }
        int dev = 0, cus = 0, per_cu = 0;
        if (hipGetDevice(&dev) != hipSuccess || hipDeviceGetAttribute(&cus, hipDeviceAttributeMultiprocessorCount, dev) != hipSuccess) { grid = -1; return; }
        if (hipFuncSetAttribute((const void*)fwd, hipFuncAttributeMaxDynamicSharedMemorySize, LDS_BYTES) != hipSuccess) { grid = -1; return; }
        if (hipOccupancyMaxActiveBlocksPerMultiprocessor(&per_cu, (const void*)fwd, NWAVES * 64, LDS_BYTES) != hipSuccess || per_cu < 1) { fprintf(stderr, "occupancy query: %d\n", per_cu); }
        (void)hipGetLastError();
        grid = cus;
    }
    if (grid < 0) return;
    (void)hipMemsetAsync((char*)d_ws + WS_CTL, 0, CTL_ZERO_BYTES, stream);
    Args a{};
    for (int i = 0; i < 16; ++i) a.in[i] = (const float*)d_in[i];
    a.out = (float*)d_out; a.ws = (unsigned char*)d_ws;
#if ONE_LAUNCH
    a.ph_lo = 0; a.ph_hi = N_PHASES;
    hipLaunchKernelGGL(fwd, dim3(grid), dim3(NWAVES * 64), LDS_BYTES, stream, a);
#else
    for (int p = 0; p < N_PHASES; ++p) {
        const int rel = (p >= 1 && p <= 12) ? (p - 1) % 6 : -1; const int l = (p - 1) / 6;
        if (rel == 1 && NAIVE_ATTN) {
            const bf16* QKV = (const bf16*)((unsigned char*)d_ws + WS_QKV); bf16* BR = (bf16*)((unsigned char*)d_ws + WS_BRX);
            const float li = 0.8f - 0.6f * expf(-0.3f * (float)l);
            const float *q1 = a.in[5] + l * 64, *k1 = a.in[6] + l * 64, *q2 = a.in[7] + l * 64, *k2 = a.in[8] + l * 64, *sw = a.in[9] + l * HD;
            const int nb = BATCH * NH * SEQ / 2;
            hipLaunchKernelGGL(naive_attn<0>, dim3(nb), dim3(128), 0, stream, QKV, BR, q1, k1, q2, k2, sw, li);
            hipLaunchKernelGGL(naive_attn<1>, dim3(nb), dim3(128), 0, stream, QKV, BR, q1, k1, q2, k2, sw, li);
            hipLaunchKernelGGL(naive_attn<2>, dim3(nb), dim3(128), 0, stream, QKV, BR, q1, k1, q2, k2, sw, li);
            if (NAIVE_ATTN == 1) continue;
        }
        a.ph_lo = p; a.ph_hi = p + 1;
        hipLaunchKernelGGL(fwd, dim3(grid), dim3(NWAVES * 64), LDS_BYTES, stream, a);
    }
#endif
}
```
